# Optimizing an MI355X kernel written in HIP

```python
import math
import jax, jax.numpy as jnp
from jax import lax
import numpy as np

D_MODEL = 1024
BATCH = 8
SEQ = 4096
DEPTH = 1

SSM_WIDTH = D_MODEL // 2
ATTN_WIDTH = D_MODEL - SSM_WIDTH
SSM_GROUP = 16
SSM_GROUPS = SSM_WIDTH // SSM_GROUP
SSM_STATE = 64
DT_MIN = 1e-3
DT_MAX = 1e-1
DA_HEADS = 4
DA_VDIM = ATTN_WIDTH // DA_HEADS
DA_QKDIM = DA_VDIM // 2
Q_BLOCK = 128
ROPE_THETA = 10000.0
MEM_LEN = 256
X_HEADS = 4
X_HEAD_DIM = D_MODEL // X_HEADS
N_EXPERTS = 64
TOP_K = 8
N_EXPERT_GROUPS = 8
TOPK_GROUPS = 4
D_EXPERT = D_MODEL // 4
D_SHARED = D_EXPERT
ROUTED_SCALE = 2.5
MOE_BLOCK = 128
EPS = 1e-6

kernel_name = "hybrid_s5_diffattn_moe_layer"


def rmsnorm(x, g):
    xf = x.astype(jnp.float32)
    y = xf * lax.rsqrt(jnp.mean(xf * xf, axis=-1, keepdims=True) + EPS)
    return (y * g.astype(jnp.float32)).astype(x.dtype)


def rope(x, positions):
    d = x.shape[-1]
    inv = ROPE_THETA ** (-jnp.arange(0, d, 2, dtype=jnp.float32) / d)
    ang = positions.astype(jnp.float32)[:, None, :, None] * inv
    cos, sin = jnp.cos(ang), jnp.sin(ang)
    xf = x.astype(jnp.float32)
    x1, x2 = xf[..., : d // 2], xf[..., d // 2:]
    return jnp.concatenate([x1 * cos - x2 * sin, x2 * cos + x1 * sin], axis=-1).astype(x.dtype)


def s5_mixer(u, a_re, a_im, log_dt, b_re, b_im, c_re, c_im, d_skip, w_glu):
    bsz, seqlen, _ = u.shape
    f32 = jnp.float32
    uf = u.astype(f32).reshape(bsz, seqlen, SSM_GROUPS, SSM_GROUP)
    lr, li = a_re.astype(f32), a_im.astype(f32)
    dt = jnp.exp(log_dt.astype(f32))[:, None]
    mag = jnp.exp(lr * dt)
    ab_re, ab_im = mag * jnp.cos(li * dt), mag * jnp.sin(li * dt)
    den = lr * lr + li * li
    zr, zi = ab_re - 1.0, ab_im
    k_re = (zr * lr + zi * li) / den
    k_im = (zi * lr - zr * li) / den
    br, bi = b_re.astype(f32), b_im.astype(f32)
    bb_re = k_re[..., None] * br - k_im[..., None] * bi
    bb_im = k_re[..., None] * bi + k_im[..., None] * br
    bu_re = jnp.einsum('blgc,gpc->blgp', uf, bb_re)
    bu_im = jnp.einsum('blgc,gpc->blgp', uf, bb_im)
    a_full_re = jnp.broadcast_to(ab_re, bu_re.shape)
    a_full_im = jnp.broadcast_to(ab_im, bu_im.shape)

    def combine(e1, e2):
        ar1, ai1, br1, bi1 = e1
        ar2, ai2, br2, bi2 = e2
        return (ar2 * ar1 - ai2 * ai1,
                ar2 * ai1 + ai2 * ar1,
                ar2 * br1 - ai2 * bi1 + br2,
                ar2 * bi1 + ai2 * br1 + bi2)

    _, _, xs_re, xs_im = lax.associative_scan(combine, (a_full_re, a_full_im, bu_re, bu_im), axis=1)
    y = (jnp.einsum('blgp,gcp->blgc', xs_re, c_re.astype(f32))
         - jnp.einsum('blgp,gcp->blgc', xs_im, c_im.astype(f32)))
    y = y.reshape(bsz, seqlen, SSM_WIDTH) + d_skip.astype(f32) * u.astype(f32)
    y = jax.nn.gelu(y)
    y = y * jax.nn.sigmoid(y @ w_glu.astype(f32))
    return y.astype(u.dtype)


def diff_attention(q, k, v, positions, lam_q1, lam_k1, lam_q2, lam_k2, g_sub, lambda_init):
    bsz, seqlen, _ = q.shape
    q = q.reshape(bsz, seqlen, 2 * DA_HEADS, DA_QKDIM).transpose(0, 2, 1, 3)
    k = k.reshape(bsz, seqlen, 2 * DA_HEADS, DA_QKDIM).transpose(0, 2, 1, 3)
    v = v.reshape(bsz, seqlen, DA_HEADS, DA_VDIM).transpose(0, 2, 1, 3)
    q = rope(q, positions) * (DA_QKDIM ** -0.5)
    k = rope(k, positions)
    f32 = jnp.float32
    lam = (jnp.exp(jnp.sum(lam_q1.astype(f32) * lam_k1.astype(f32)))
           - jnp.exp(jnp.sum(lam_q2.astype(f32) * lam_k2.astype(f32))) + lambda_init)
    n_blocks = seqlen // Q_BLOCK
    qb = q.reshape(bsz, 2 * DA_HEADS, n_blocks, Q_BLOCK, DA_QKDIM).transpose(2, 0, 1, 3, 4)
    kpos = jnp.arange(seqlen)

    def block(args):
        qi, bi = args
        s = jnp.einsum('bhqd,bhkd->bhqk', qi, k).astype(f32)
        qpos = bi * Q_BLOCK + jnp.arange(Q_BLOCK)
        s = jnp.where(kpos[None, :] <= qpos[:, None], s, jnp.finfo(f32).min)
        p = jax.nn.softmax(s, axis=-1).reshape(bsz, DA_HEADS, 2, Q_BLOCK, seqlen)
        w = p[:, :, 0] - lam * p[:, :, 1]
        return jnp.einsum('bhqk,bhkd->bhqd', w.astype(v.dtype), v)

    o = lax.map(block, (qb, jnp.arange(n_blocks)))
    o = o.transpose(1, 0, 3, 2, 4).reshape(bsz, seqlen, DA_HEADS, DA_VDIM)
    o = rmsnorm(o, g_sub) * (1.0 - lambda_init)
    return o.reshape(bsz, seqlen, ATTN_WIDTH)


def cross_attention(hq, m, wq, wk, wv, wo):
    bsz, seqlen, _ = hq.shape
    q = (hq @ wq).reshape(bsz, seqlen, X_HEADS, X_HEAD_DIM)
    k = (m @ wk).reshape(bsz, m.shape[1], X_HEADS, X_HEAD_DIM)
    v = (m @ wv).reshape(bsz, m.shape[1], X_HEADS, X_HEAD_DIM)
    s = jnp.einsum('blhd,bmhd->bhlm', q, k).astype(jnp.float32) * (X_HEAD_DIM ** -0.5)
    p = jax.nn.softmax(s, axis=-1)
    o = jnp.einsum('bhlm,bmhd->blhd', p.astype(v.dtype), v).reshape(bsz, seqlen, D_MODEL)
    return o @ wo


def moe(hn, w_router, router_bias, w_gate, w_up, w_down, ws_gate, ws_up, ws_down):
    bsz, seqlen, d = hn.shape
    n_tok = bsz * seqlen
    t = hn.reshape(n_tok, d)
    f32 = jnp.float32
    scores = jax.nn.sigmoid((t @ w_router).astype(f32))
    biased = scores + router_bias.astype(f32)
    per_group = N_EXPERTS // N_EXPERT_GROUPS
    grp_score = lax.top_k(biased.reshape(n_tok, N_EXPERT_GROUPS, per_group), 2)[0].sum(-1)
    _, gidx = lax.top_k(grp_score, TOPK_GROUPS)
    gmask = jnp.any(gidx[..., None] == jnp.arange(N_EXPERT_GROUPS), axis=1)
    masked = jnp.where(jnp.repeat(gmask, per_group, axis=1), biased, -jnp.inf)
    _, eidx = lax.top_k(masked, TOP_K)
    gw = jnp.take_along_axis(scores, eidx, axis=1)
    gw = gw / jnp.sum(gw, axis=-1, keepdims=True) * ROUTED_SCALE

    n_assign = n_tok * TOP_K
    e_flat = eidx.reshape(n_assign)
    tok_flat = jnp.arange(n_assign, dtype=jnp.int32) // TOP_K
    g_flat = gw.reshape(n_assign)
    order = jnp.argsort(e_flat)
    e_sorted, tok_sorted, g_sorted = e_flat[order], tok_flat[order], g_flat[order]
    counts = jnp.bincount(e_flat, length=N_EXPERTS)
    start = jnp.cumsum(counts) - counts
    padded = ((counts + MOE_BLOCK - 1) // MOE_BLOCK) * MOE_BLOCK
    pend = jnp.cumsum(padded)
    pstart = pend - padded
    dest = pstart[e_sorted] + jnp.arange(n_assign) - start[e_sorted]
    n_slots = n_assign + N_EXPERTS * MOE_BLOCK
    n_blocks = n_slots // MOE_BLOCK
    tok_buf = jnp.full((n_slots,), n_tok, jnp.int32).at[dest].set(tok_sorted)
    g_buf = jnp.zeros((n_slots,), f32).at[dest].set(g_sorted)
    block_e = jnp.minimum(jnp.searchsorted(pend, jnp.arange(n_blocks) * MOE_BLOCK, side='right'),
                          N_EXPERTS - 1)
    t_pad = jnp.concatenate([t, jnp.zeros((1, d), t.dtype)], axis=0)

    def expert_block(args):
        tok, g, e = args
        xb = t_pad[tok]
        hid = jax.nn.silu(xb @ w_gate[e]) * (xb @ w_up[e])
        return (hid @ w_down[e]) * g[:, None].astype(xb.dtype)

    yb = lax.map(expert_block, (tok_buf.reshape(n_blocks, MOE_BLOCK),
                                g_buf.reshape(n_blocks, MOE_BLOCK), block_e))
    routed = jax.ops.segment_sum(yb.reshape(n_slots, d), tok_buf, num_segments=n_tok + 1)[:n_tok]
    shared = (jax.nn.silu(t @ ws_gate) * (t @ ws_up)) @ ws_down
    return (routed + shared).reshape(bsz, seqlen, d)


def setup_inputs(seed: int = 0) -> dict:
    key = jax.random.key(seed)
    ks = iter(jax.random.split(key, 64))
    f32 = jnp.float32

    def nrm(shape, scale):
        return jax.random.normal(next(ks), shape, f32) * scale

    def gain(shape):
        return 1.0 + 0.02 * jax.random.normal(next(ks), shape, f32)

    L, G, P, C = DEPTH, SSM_GROUPS, SSM_STATE, SSM_GROUP
    inp = {}
    inp["x"] = jax.random.normal(next(ks), (BATCH, SEQ, D_MODEL), f32)
    inp["mem"] = jax.random.normal(next(ks), (BATCH, MEM_LEN, D_MODEL), f32)
    offs = jax.random.randint(next(ks), (BATCH, 1), 0, 1024, jnp.int32)
    inp["positions"] = (jnp.arange(SEQ, dtype=jnp.int32)[None, :] + offs).astype(jnp.int32)
    inp["g_mix"] = gain((L, D_MODEL))
    inp["w_in"] = nrm((L, D_MODEL, SSM_WIDTH + 3 * ATTN_WIDTH), D_MODEL ** -0.5)
    inp["a_re"] = -0.5 + 0.01 * jax.random.normal(next(ks), (L, G, P), f32)
    inp["a_im"] = jnp.pi * jnp.arange(P, dtype=f32) + 0.01 * jax.random.normal(next(ks), (L, G, P), f32)
    inp["log_dt"] = jax.random.uniform(next(ks), (L, G), f32, math.log(DT_MIN), math.log(DT_MAX))
    inp["b_re"] = nrm((L, G, P, C), (2.0 * C) ** -0.5)
    inp["b_im"] = nrm((L, G, P, C), (2.0 * C) ** -0.5)
    inp["c_re"] = nrm((L, G, C, P), (2.0 * P) ** -0.5)
    inp["c_im"] = nrm((L, G, C, P), (2.0 * P) ** -0.5)
    inp["d_skip"] = nrm((L, SSM_WIDTH), 1.0)
    inp["w_glu"] = nrm((L, SSM_WIDTH, SSM_WIDTH), SSM_WIDTH ** -0.5)
    inp["g_ssm_out"] = gain((L, SSM_WIDTH))
    inp["lam_q1"] = nrm((L, DA_QKDIM), 0.1)
    inp["lam_k1"] = nrm((L, DA_QKDIM), 0.1)
    inp["lam_q2"] = nrm((L, DA_QKDIM), 0.1)
    inp["lam_k2"] = nrm((L, DA_QKDIM), 0.1)
    inp["g_sub"] = gain((L, DA_VDIM))
    inp["w_out"] = nrm((L, D_MODEL, D_MODEL), D_MODEL ** -0.5)
    inp["g_x"] = gain((L, D_MODEL))
    inp["g_mem"] = gain((L, D_MODEL))
    inp["wq_x"] = nrm((L, D_MODEL, D_MODEL), D_MODEL ** -0.5)
    inp["wk_x"] = nrm((L, D_MODEL, D_MODEL), D_MODEL ** -0.5)
    inp["wv_x"] = nrm((L, D_MODEL, D_MODEL), D_MODEL ** -0.5)
    inp["wo_x"] = nrm((L, D_MODEL, D_MODEL), D_MODEL ** -0.5)
    inp["g_ffn"] = gain((L, D_MODEL))
    inp["w_router"] = nrm((L, D_MODEL, N_EXPERTS), D_MODEL ** -0.5)
    inp["router_bias"] = nrm((L, N_EXPERTS), 0.01)
    inp["w_gate"] = nrm((L, N_EXPERTS, D_MODEL, D_EXPERT), D_MODEL ** -0.5)
    inp["w_up"] = nrm((L, N_EXPERTS, D_MODEL, D_EXPERT), D_MODEL ** -0.5)
    inp["w_down"] = nrm((L, N_EXPERTS, D_EXPERT, D_MODEL), D_EXPERT ** -0.5)
    inp["ws_gate"] = nrm((L, D_MODEL, D_SHARED), D_MODEL ** -0.5)
    inp["ws_up"] = nrm((L, D_MODEL, D_SHARED), D_MODEL ** -0.5)
    inp["ws_down"] = nrm((L, D_SHARED, D_MODEL), D_SHARED ** -0.5)
    inp["g_final"] = gain((D_MODEL,))
    return inp


def reference(x, mem, positions, g_mix, w_in, a_re, a_im, log_dt, b_re, b_im, c_re, c_im,
              d_skip, w_glu, g_ssm_out, lam_q1, lam_k1, lam_q2, lam_k2, g_sub, w_out,
              g_x, g_mem, wq_x, wk_x, wv_x, wo_x, g_ffn, w_router, router_bias,
              w_gate, w_up, w_down, ws_gate, ws_up, ws_down, g_final):
    h = x
    for l in range(DEPTH):
        lambda_init = 0.8 - 0.6 * math.exp(-0.3 * l)
        a = rmsnorm(h, g_mix[l])
        z = a @ w_in[l]
        u = z[..., :SSM_WIDTH]
        q = z[..., SSM_WIDTH:SSM_WIDTH + ATTN_WIDTH]
        k = z[..., SSM_WIDTH + ATTN_WIDTH:SSM_WIDTH + 2 * ATTN_WIDTH]
        v = z[..., SSM_WIDTH + 2 * ATTN_WIDTH:]
        y_ssm = rmsnorm(s5_mixer(u, a_re[l], a_im[l], log_dt[l], b_re[l], b_im[l],
                                 c_re[l], c_im[l], d_skip[l], w_glu[l]), g_ssm_out[l])
        y_att = diff_attention(q, k, v, positions, lam_q1[l], lam_k1[l], lam_q2[l], lam_k2[l],
                               g_sub[l], lambda_init)
        h = h + jnp.concatenate([y_ssm, y_att], axis=-1) @ w_out[l]
        h = h + cross_attention(rmsnorm(h, g_x[l]), rmsnorm(mem, g_mem[l]),
                                wq_x[l], wk_x[l], wv_x[l], wo_x[l])
        h = h + moe(rmsnorm(h, g_ffn[l]), w_router[l], router_bias[l], w_gate[l], w_up[l],
                    w_down[l], ws_gate[l], ws_up[l], ws_down[l])
    return rmsnorm(h, g_final)
```

```cpp
#include <hip/hip_runtime.h>
#include <cstdio>
#include <cstdint>

#ifndef MK_ONE_LAUNCH
#define MK_ONE_LAUNCH 1
#endif

#define GAS __attribute__((address_space(1)))
typedef unsigned short bf16_t;
typedef short bf16x8 __attribute__((ext_vector_type(8)));
typedef float f32x4 __attribute__((ext_vector_type(4)));
typedef float f32x16 __attribute__((ext_vector_type(16)));
typedef unsigned u32x4 __attribute__((ext_vector_type(4)));
typedef unsigned u32x2 __attribute__((ext_vector_type(2)));
typedef float f32x2_t __attribute__((ext_vector_type(2)));
typedef __bf16 bf16x2_t __attribute__((ext_vector_type(2)));

constexpr int NB = 8, SEQ = 4096, DM = 1024, NTOK = NB * SEQ;
constexpr int MEML = 256, NMEM = NB * MEML;
constexpr int NEXP = 64, TOPK = 8, DEXP = 256;
constexpr int NASSIGN = NTOK * TOPK;
constexpr int NQ = 3;
__host__ __device__ constexpr int QVB(int q) { return (q * 256) / 3; }
constexpr int QTOK = 86 * 128;
constexpr int MAXSLOT = NASSIGN + NQ * NEXP * 256;
constexpr int QSLOT = QTOK * TOPK + NEXP * 256;
constexpr float EPS = 1e-6f;
constexpr float LOG2E = 1.4426950408889634f;
constexpr float C2Q = 0.125f * LOG2E;
constexpr float CXQ = 0.0625f * LOG2E;
constexpr float LAMBDA_INIT = 0.2f;
constexpr float YSC = 32.0f;

constexpr size_t MiB = 1u << 20;
constexpr size_t WS_CTL = 0, CTL_BYTES = 1 * MiB;
constexpr int CW_BAR = 4096;
constexpr int CW_CNT = 8192;
constexpr int CW_LAM = 8512;
constexpr size_t CB_SSQ0 = 64 * 1024, CB_SSQ1 = 192 * 1024, CB_SSQ2 = 320 * 1024;
constexpr size_t CB_BLKHIST = 448 * 1024;
constexpr size_t WS_WIN = 1 * MiB;
constexpr size_t WS_WV = 4 * MiB;
constexpr size_t WS_WGLU = 5 * MiB;
constexpr size_t WS_WR = 5 * MiB + 512 * 1024;
constexpr size_t WS_WSD = 5 * MiB + 768 * 1024;
constexpr size_t WS_WOUT = 7 * MiB, WS_WQX = 9 * MiB, WS_WKX = 11 * MiB, WS_WVX = 13 * MiB, WS_WOX = 15 * MiB;
constexpr size_t WS_WSGU = 17 * MiB;
constexpr size_t WS_WGU = 18 * MiB;
constexpr size_t WS_WD = 82 * MiB;
constexpr size_t WS_WST = 496 * MiB;
constexpr size_t WS_WYT = 122 * MiB;
constexpr size_t WS_KD = 166 * MiB;
constexpr int KDG = 127 * 256;
constexpr size_t WS_ROPE = 131 * MiB;
constexpr size_t WS_MEMN = 139 * MiB, WS_KX = 143 * MiB, WS_VXT = 147 * MiB;
constexpr size_t WS_S = 151 * MiB;
constexpr size_t WS_E = 159 * MiB;
constexpr size_t WS_LOGIT = 163 * MiB;
constexpr size_t WS_POWT = 163 * MiB;
constexpr size_t WS_BBAR = 165 * MiB;
constexpr size_t WS_EIDX = 171 * MiB, WS_GW = 172 * MiB, WS_SLOT = 173 * MiB;
constexpr size_t WS_SLOTW = 146 * MiB + 512 * 1024, WS_SLOTRS = 148 * MiB + 512 * 1024;
constexpr size_t WS_A0 = 176 * MiB;
constexpr size_t WS_U2 = 240 * MiB;
constexpr size_t WS_Q = 272 * MiB, WS_K = 304 * MiB, WS_VT = 336 * MiB;
constexpr size_t WS_YCAT = 368 * MiB;
constexpr size_t WS_O1S = 464 * MiB;
constexpr size_t WS_QX = 272 * MiB;
constexpr size_t WS_PX = 368 * MiB;
constexpr size_t WS_YG = 432 * MiB;
constexpr size_t WS_OX = 432 * MiB;
constexpr size_t WS_HID = 240 * MiB;
constexpr size_t WS_HIDS = 292 * MiB;
constexpr size_t WS_Y = 308 * MiB;
constexpr size_t WS_YSLO = 480 * MiB, WS_YSHI = 114 * MiB;
constexpr size_t WS_END = 512 * MiB;
static_assert(WS_HID + (size_t)QSLOT * 512 <= WS_HIDS && WS_SLOT + (size_t)MAXSLOT * 4 <= WS_A0 && WS_Y + (size_t)QTOK * 8 * 2048 <= WS_END, "moe map");

constexpr int LDS_GBUF = 49152;
constexpr int LDS_SCR = 2 * LDS_GBUF;
constexpr int LDS_SCR8 = 131072;
constexpr int LDS_TAB = 139264;
constexpr int LDS_MISC = 146432;
constexpr int LDS_BYTES = 147456;

__device__ __forceinline__ unsigned pk2(float lo, float hi) { f32x2_t v = {lo, hi}; bf16x2_t b = __builtin_convertvector(v, bf16x2_t); return __builtin_bit_cast(unsigned, b); }
__device__ __forceinline__ float bflo(unsigned w) { return __uint_as_float(w << 16); }
__device__ __forceinline__ float bfhi(unsigned w) { return __uint_as_float(w & 0xffff0000u); }
#define SHX(v, M) __builtin_bit_cast(float, __builtin_amdgcn_ds_swizzle(__builtin_bit_cast(int, (float)(v)), ((M) << 10) | 0x1f))
__device__ __forceinline__ float sh32_sum(float v) { auto rr = __builtin_amdgcn_permlane32_swap(__float_as_uint(v), __float_as_uint(v), false, false); return __uint_as_float(rr[0]) + __uint_as_float(rr[1]); }
__device__ __forceinline__ float sh32_max(float v) { auto rr = __builtin_amdgcn_permlane32_swap(__float_as_uint(v), __float_as_uint(v), false, false); return fmaxf(__uint_as_float(rr[0]), __uint_as_float(rr[1])); }
__device__ __forceinline__ float wave_sum(float v) { v += SHX(v, 1); v += SHX(v, 2); v += SHX(v, 4); v += SHX(v, 8); v += SHX(v, 16); return sh32_sum(v); }
__device__ __forceinline__ float wave_max(float v) { v = fmaxf(v, SHX(v, 1)); v = fmaxf(v, SHX(v, 2)); v = fmaxf(v, SHX(v, 4)); v = fmaxf(v, SHX(v, 8)); v = fmaxf(v, SHX(v, 16)); return sh32_max(v); }
#define DPPF(v, ctrl, rmask) __builtin_bit_cast(float, __builtin_amdgcn_update_dpp(__builtin_bit_cast(int, (float)(v)), __builtin_bit_cast(int, (float)(v)), (ctrl), (rmask), 0xF, false))
__device__ __forceinline__ float max8_dpp(float t) { t = fmaxf(t, DPPF(t, 0xB1, 0xF)); t = fmaxf(t, DPPF(t, 0x4E, 0xF)); t = fmaxf(t, DPPF(t, 0x141, 0xF)); return t; }
__device__ __forceinline__ float wave_max_dpp(float t) { t = max8_dpp(t); t = fmaxf(t, DPPF(t, 0x140, 0xF)); t = fmaxf(t, DPPF(t, 0x142, 0xA)); t = fmaxf(t, DPPF(t, 0x143, 0xC));
    return __uint_as_float(__builtin_amdgcn_readlane(__float_as_uint(t), 63)); }
#define LDS_WAIT() asm volatile("s_waitcnt lgkmcnt(0)" ::: "memory")

#define LAS __attribute__((address_space(3)))
#define XB_TMO      128
#define XB_XCNT(j)  (256  + 64 * (j))
#define XB_XSUB(j)  (1280 + 64 * (j))
#define XB_XGEN(j)  (2304 + 64 * (j))
#define XB_TOP      3328
#define XB_TOPGEN   3392
#define XCD_BAR_WORDS 3456
#define XB_SPIN_CAP (1u << 18)

__device__ __forceinline__ unsigned xb_ld(unsigned* p)              { return __hip_atomic_load(p, __ATOMIC_RELAXED, __HIP_MEMORY_SCOPE_AGENT); }
__device__ __forceinline__ unsigned xb_add(unsigned* p, unsigned v) { return __hip_atomic_fetch_add(p, v, __ATOMIC_RELAXED, __HIP_MEMORY_SCOPE_AGENT); }
__device__ __forceinline__ unsigned xb_xcc_id() { return (unsigned)__builtin_amdgcn_s_getreg((3 << 11) | 20) & 0xFu; }
#define XB_SPIN(cond, bar) do { unsigned _sp = 0; while (cond) { __builtin_amdgcn_s_sleep(1); \
    if ((++_sp & 255u) == 0u) { if (xb_ld(&(bar)[XB_TMO])) break; if (_sp > XB_SPIN_CAP) { atomicAdd(&(bar)[XB_TMO], 1u); break; } } } } while (0)

struct XcdBarrier {
    unsigned* bar; unsigned x;
    volatile LAS unsigned* st;
};

__device__ __forceinline__ XcdBarrier xcd_barrier_post(unsigned* bar, volatile LAS unsigned* st) {
    XcdBarrier b; b.bar = bar; b.x = xb_xcc_id(); b.st = st;
    if (threadIdx.x == 0) (void)xb_add(&bar[XB_XCNT(b.x)], 1u);
    return b;
}
__device__ __forceinline__ void xcd_barrier_complete(unsigned* bar, unsigned x, unsigned& nloc, unsigned& nx) {
    const unsigned G = gridDim.x * gridDim.y * gridDim.z;
    unsigned sum, cnt, mine, sp = 0u;
    for (;;) {
        sum = 0u; cnt = 0u; mine = 0u;
#pragma unroll
        for (unsigned j = 0; j < 16; ++j) { const unsigned c = xb_ld(&bar[XB_XCNT(j)]); sum += c; cnt += (c > 0u) ? 1u : 0u; mine = (j == x) ? c : mine; }
        if (sum == G) break;
        __builtin_amdgcn_s_sleep(1);
        if ((++sp & 255u) == 0u) { if (xb_ld(&bar[XB_TMO])) break; if (sp > XB_SPIN_CAP) { atomicAdd(&bar[XB_TMO], 1u); break; } }
    }
    nloc = mine > 0u ? mine : 1u; nx = cnt > 0u ? cnt : 1u;
}

__device__ __forceinline__ void xcd_barrier(const XcdBarrier& b) {
    asm volatile("s_waitcnt vmcnt(0)" ::: "memory");
    __syncthreads();
    if (threadIdx.x == 0) {
        unsigned* bar = b.bar;
        __builtin_amdgcn_s_waitcnt(0);
        unsigned nloc = b.st[0], nx = b.st[1];
        if (nloc == 0u) { xcd_barrier_complete(bar, b.x, nloc, nx); b.st[0] = nloc; b.st[1] = nx; }
        const unsigned old = xb_add(&bar[XB_XSUB(b.x)], 1u);
        const unsigned gen = old / nloc;
        if (old + 1u == (gen + 1u) * nloc) {
            __builtin_amdgcn_fence(__ATOMIC_RELEASE, "agent");
            asm volatile("s_waitcnt vmcnt(0)" ::: "memory");
            const unsigned og = xb_add(&bar[XB_TOP], 1u);
            const unsigned tg = og / nx;
            if (og + 1u == (tg + 1u) * nx) xb_add(&bar[XB_TOPGEN], 1u);
            else XB_SPIN(xb_ld(&bar[XB_TOPGEN]) == tg, bar);
            __builtin_amdgcn_fence(__ATOMIC_ACQUIRE, "agent");
            xb_add(&bar[XB_XGEN(b.x)], 1u);
            asm volatile("s_waitcnt vmcnt(0)" ::: "memory");
        } else {
            XB_SPIN(xb_ld(&bar[XB_XGEN(b.x)]) == gen, bar);
            __builtin_amdgcn_fence(__ATOMIC_ACQUIRE, "agent");
            asm volatile("s_waitcnt vmcnt(0)" ::: "memory");
        }
    }
    __syncthreads();
}


struct UPlain {
    const char* A; const char* B; unsigned lda, ldb; int nk; int nvalid;
    __device__ __forceinline__ const char* arow(int r) const { return A + (size_t)r * lda; }
    __device__ __forceinline__ const char* brow(int r) const { return B + (size_t)(r < nvalid ? r : 0) * ldb; }
    __device__ __forceinline__ u32x4 aload(const char* p, int c, int kt) const { return *(const u32x4*)(p + kt * 128 + c * 16); }
    __device__ __forceinline__ u32x4 bload(const char* p, int r, int c, int kt) const {
        u32x4 v = *(const u32x4*)(p + kt * 128 + c * 16); if (r >= nvalid) v = (u32x4){0u, 0u, 0u, 0u}; return v; }
};
struct UToep {
    const char* A; unsigned lda; const char* KD; int nk; int pn;
    __device__ __forceinline__ const char* arow(int r) const { return A + (size_t)r * lda; }
    __device__ __forceinline__ const char* brow(int r) const { const int n = pn * 256 + r; return KD + ((n >> 4) * 256 + (n & 15) * 16) * 2; }
    __device__ __forceinline__ u32x4 aload(const char* p, int c, int kt) const { return *(const u32x4*)(p + kt * 128 + c * 16); }
    __device__ __forceinline__ u32x4 bload(const char* p, int r, int c, int kt) const {
        const int n = pn * 256 + r, tp = n >> 4, s = kt * 4 + (c >> 1);
        u32x4 v = (u32x4){0u, 0u, 0u, 0u};
        if (s <= tp) v = *(const u32x4*)(p - s * 512 + (c & 1) * 16);
        return v; }
};

struct UGather { const char* HBp; const int* aid; const char* B; int nk;
    __device__ __forceinline__ const char* arow(int r) const { const int a = aid[r]; return HBp + (size_t)(a < 0 ? 0 : (a >> 3)) * 2048; }
    __device__ __forceinline__ const char* brow(int r) const { return B + (size_t)r * 2048; }
    __device__ __forceinline__ u32x4 aload(const char* p, int c, int kt) const { return *(const u32x4*)(p + kt * 128 + c * 16); }
    __device__ __forceinline__ u32x4 bload(const char* p, int r, int c, int kt) const { return *(const u32x4*)(p + kt * 128 + c * 16); } };

template <class U, class E>
__device__ __forceinline__ void gemm_unit(LAS unsigned char* lds, const U& u, E& e) {
    int tid = threadIdx.x; asm volatile("" : "+v"(tid));
    const int lane = tid & 63;
    const int wid = __builtin_amdgcn_readfirstlane(tid >> 6);
    const int wr = wid >> 2, wc = wid & 3, fr = lane & 15, fq = lane >> 4;
    const int sr = tid >> 3, sc = tid & 7;
    const unsigned st = (unsigned)(sr * 128 + ((sc ^ ((sr >> 1) & 7)) << 4));
    const char* ap0 = u.arow(sr); const char* ap1 = u.arow(sr + 64);
    const char* bp0 = u.brow(sr); const char* bp1 = u.brow(sr + 64); const char* bp2 = u.brow(sr + 128); const char* bp3 = u.brow(sr + 192);
    const unsigned c0 = (unsigned)((fq ^ ((fr >> 1) & 7)) << 4), c1 = c0 ^ 64u;
    const unsigned aoff = (unsigned)((wr * 64 + fr) * 128);
    const unsigned boff = 16384u + (unsigned)((wc * 64 + fr) * 128);
    f32x4 acc[4][4];
#pragma unroll
    for (int m = 0; m < 4; ++m)
#pragma unroll
        for (int n = 0; n < 4; ++n) acc[m][n] = (f32x4){0.f, 0.f, 0.f, 0.f};
    const int nk = u.nk;
    u32x4 ra0 = u.aload(ap0, sc, 0), ra1 = u.aload(ap1, sc, 0);
    u32x4 rb0 = u.bload(bp0, sr, sc, 0), rb1 = u.bload(bp1, sr + 64, sc, 0), rb2 = u.bload(bp2, sr + 128, sc, 0), rb3 = u.bload(bp3, sr + 192, sc, 0);
    *(LAS u32x4*)(lds + st) = ra0; *(LAS u32x4*)(lds + st + 8192) = ra1;
    *(LAS u32x4*)(lds + 16384 + st) = rb0; *(LAS u32x4*)(lds + 16384 + st + 8192) = rb1;
    *(LAS u32x4*)(lds + 16384 + st + 16384) = rb2; *(LAS u32x4*)(lds + 16384 + st + 24576) = rb3;
    __syncthreads();
    for (int kt = 0; kt < nk; ++kt) {
        const unsigned cur = (unsigned)(kt & 1) * (unsigned)LDS_GBUF, nxt = (unsigned)LDS_GBUF - cur;
        const bool more = kt + 1 < nk;
        if (more) {
            ra0 = u.aload(ap0, sc, kt + 1); ra1 = u.aload(ap1, sc, kt + 1);
            rb0 = u.bload(bp0, sr, sc, kt + 1); rb1 = u.bload(bp1, sr + 64, sc, kt + 1); rb2 = u.bload(bp2, sr + 128, sc, kt + 1); rb3 = u.bload(bp3, sr + 192, sc, kt + 1);
        }
#pragma unroll
        for (int kk = 0; kk < 2; ++kk) {
            const unsigned ck = kk ? c1 : c0;
            bf16x8 af[4], bfr[4];
#pragma unroll
            for (int m = 0; m < 4; ++m) af[m] = *(const LAS bf16x8*)(lds + cur + aoff + m * 2048 + ck);
#pragma unroll
            for (int n = 0; n < 4; ++n) bfr[n] = *(const LAS bf16x8*)(lds + cur + boff + n * 2048 + ck);
#pragma unroll
            for (int m = 0; m < 4; ++m)
#pragma unroll
                for (int n = 0; n < 4; ++n) acc[m][n] = __builtin_amdgcn_mfma_f32_16x16x32_bf16(bfr[n], af[m], acc[m][n], 0, 0, 0);
        }
        if constexpr (E::HAS_MID) e.mid(kt, acc, wr, fr);
        if (more) {
            *(LAS u32x4*)(lds + nxt + st) = ra0; *(LAS u32x4*)(lds + nxt + st + 8192) = ra1;
            *(LAS u32x4*)(lds + nxt + 16384 + st) = rb0; *(LAS u32x4*)(lds + nxt + 16384 + st + 8192) = rb1;
            *(LAS u32x4*)(lds + nxt + 16384 + st + 16384) = rb2; *(LAS u32x4*)(lds + nxt + 16384 + st + 24576) = rb3;
        }
        __syncthreads();
    }
    e(acc, wr, wc, fr, fq);
}

template <class U, class E>
__device__ __forceinline__ void gemm_unit64(LAS unsigned char* lds, const U& u, E& e) {
    int tid = threadIdx.x; asm volatile("" : "+v"(tid));
    const int lane = tid & 63;
    const int wid = __builtin_amdgcn_readfirstlane(tid >> 6);
    const int wr = wid >> 2, wc = wid & 3, fr = lane & 15, fq = lane >> 4;
    const int sr = tid >> 3, sc = tid & 7;
    const unsigned st = (unsigned)(sr * 128 + ((sc ^ ((sr >> 1) & 7)) << 4));
    const char* ap0 = u.arow(sr); const char* ap1 = u.arow(sr + 64);
    const char* bp0 = u.brow(sr);
    const unsigned c0 = (unsigned)((fq ^ ((fr >> 1) & 7)) << 4), c1 = c0 ^ 64u;
    const unsigned aoff = (unsigned)((wr * 64 + fr) * 128);
    const unsigned boff = 16384u + (unsigned)((wc * 16 + fr) * 128);
    f32x4 acc[4];
#pragma unroll
    for (int m = 0; m < 4; ++m) acc[m] = (f32x4){0.f, 0.f, 0.f, 0.f};
    const int nm = u.nk >> 2;
    u32x4 ra[4][2], rb[4];
#pragma unroll
    for (int s = 0; s < 4; ++s) { ra[s][0] = u.aload(ap0, sc, s); ra[s][1] = u.aload(ap1, sc, s); rb[s] = u.bload(bp0, sr, sc, s); }
    for (int mt = 0; mt < nm; ++mt) {
#pragma unroll
        for (int s = 0; s < 4; ++s) { *(LAS u32x4*)(lds + s * 24576 + st) = ra[s][0]; *(LAS u32x4*)(lds + s * 24576 + st + 8192) = ra[s][1]; *(LAS u32x4*)(lds + s * 24576 + 16384 + st) = rb[s]; }
        __syncthreads();
        if (mt + 1 < nm) {
#pragma unroll
            for (int s = 0; s < 4; ++s) { ra[s][0] = u.aload(ap0, sc, (mt + 1) * 4 + s); ra[s][1] = u.aload(ap1, sc, (mt + 1) * 4 + s); rb[s] = u.bload(bp0, sr, sc, (mt + 1) * 4 + s); }
        }
#pragma unroll
        for (int s = 0; s < 4; ++s)
#pragma unroll
            for (int kk = 0; kk < 2; ++kk) {
                const unsigned ck = kk ? c1 : c0;
                bf16x8 af[4];
#pragma unroll
                for (int m = 0; m < 4; ++m) af[m] = *(const LAS bf16x8*)(lds + s * 24576 + aoff + m * 2048 + ck);
                const bf16x8 bfr = *(const LAS bf16x8*)(lds + s * 24576 + boff + ck);
#pragma unroll
                for (int m = 0; m < 4; ++m) acc[m] = __builtin_amdgcn_mfma_f32_16x16x32_bf16(bfr, af[m], acc[m], 0, 0, 0);
            }
        __syncthreads();
    }
    e(acc, wr, wc, fr, fq);
}

#define EPI_LOOP for (int m = 0; m < 4; ++m) _Pragma("unroll") for (int n = 0; n < 4; ++n)
__device__ __forceinline__ void st4bf(bf16_t* p, f32x4 v) { u32x2 w; w.x = pk2(v[0], v[1]); w.y = pk2(v[2], v[3]); *(u32x2*)p = w; }

struct EInproj {
    static constexpr bool HAS_MID = false;
    int mt, nt; bf16_t* U2; bf16_t* Q; bf16_t* K; const float* rope;
    __device__ __forceinline__ void operator()(f32x4 (&acc)[4][4], int wr, int wc, int fr, int fq) {
#pragma unroll
        EPI_LOOP {
            const int tok = mt * 128 + wr * 64 + m * 16 + fr, col = nt * 256 + wc * 64 + n * 16 + 4 * fq; const f32x4 v = acc[m][n];
            if (nt < 2) { st4bf(U2 + ((size_t)(col >> 4) * NTOK + tok) * 16 + (col & 15), v); }
            else { const int which = nt >= 4, cc = col - (which ? 1024 : 512), j = (cc & 63) >> 1;
                const f32x4 cs = *(const f32x4*)(rope + ((size_t)tok * 32 + j) * 2);
                f32x4 o; o[0] = v[0] * cs[0] - v[1] * cs[1]; o[1] = v[1] * cs[0] + v[0] * cs[1]; o[2] = v[2] * cs[2] - v[3] * cs[3]; o[3] = v[3] * cs[2] + v[2] * cs[3];
                if (!which) o = o * C2Q;
                st4bf((which ? K : Q) + (size_t)tok * 512 + cc, o); }
        }
    }
};
struct EPlain {
    static constexpr bool HAS_MID = false;
    bf16_t* out; size_t ldc; const float* ssq; float cscale; int ncol;
    __device__ __forceinline__ void operator()(f32x4 (&acc)[4][4], int wr, int wc, int fr, int fq) {
#pragma unroll
        for (int m = 0; m < 4; ++m) { const int r = wr * 64 + m * 16 + fr; float rs = cscale; if (ssq) rs *= rsqrtf(ssq[r] * (1.0f / 1024.0f) + EPS);
#pragma unroll
            for (int n = 0; n < 4; ++n) { const int c = wc * 64 + n * 16 + 4 * fq; if (c < ncol) st4bf(out + (size_t)r * ldc + c, acc[m][n] * rs); } }
    }
};
struct EF32 {
    static constexpr bool HAS_MID = false;
    float* out; size_t ldc; const float* ssq; int ncol;
    __device__ __forceinline__ void operator()(f32x4 (&acc)[4][4], int wr, int wc, int fr, int fq) {
#pragma unroll
        for (int m = 0; m < 4; ++m) { const int r = wr * 64 + m * 16 + fr; float rs = 1.0f; if (ssq) rs = rsqrtf(ssq[r] * (1.0f / 1024.0f) + EPS);
#pragma unroll
            for (int n = 0; n < 4; ++n) { const int c = wc * 64 + n * 16 + 4 * fq; if (c < ncol) *(f32x4*)(out + (size_t)r * ldc + c) = acc[m][n] * rs; } }
    }
};
struct ELdsF32 {
    LAS float* out; const float* ssq;
    __device__ __forceinline__ void operator()(f32x4 (&acc)[4], int wr, int wc, int fr, int fq) {
#pragma unroll
        for (int m = 0; m < 4; ++m) { const int r = wr * 64 + m * 16 + fr; const float rs = rsqrtf(ssq[r] * (1.0f / 1024.0f) + EPS);
            *(LAS f32x4*)(out + r * 64 + wc * 16 + 4 * fq) = acc[m] * rs; }
    }
};
struct ESsmT {
    static constexpr bool HAS_MID = false;
    int g, mt, pn; float* Y;
    __device__ __forceinline__ void operator()(f32x4 (&acc)[4][4], int wr, int wc, int fr, int fq) {
#pragma unroll
        EPI_LOOP { const int rr = mt * 128 + wr * 64 + m * 16 + fr, nn = pn * 256 + wc * 64 + n * 16 + 4 * fq;
            const int tok = (rr >> 6) * SEQ + (rr & 63) * 64 + (nn >> 4);
            *(f32x4*)(Y + (size_t)tok * 512 + g * 16 + (nn & 15)) = acc[m][n]; }
    }
};
__device__ __forceinline__ float gelu_tanh(float x) {
    const float u = 0.7978845608028654f * (x + 0.044715f * x * x * x);
    const float t = 1.0f - 2.0f / (1.0f + __expf(2.0f * u));
    return 0.5f * x * (1.0f + t);
}
struct EYstate {
    static constexpr bool HAS_MID = false;
    int g, mt, pn; const float* Y; const bf16_t* U2; const float* dskip; bf16_t* YG;
    __device__ __forceinline__ void operator()(f32x4 (&acc)[4][4], int wr, int wc, int fr, int fq) {
#pragma unroll
        EPI_LOOP { const int rr = mt * 128 + wr * 64 + m * 16 + fr, nn = pn * 256 + wc * 64 + n * 16 + 4 * fq;
            const int tok = (rr >> 6) * SEQ + (rr & 63) * 64 + (nn >> 4), c = nn & 15;
            const f32x4 yi = *(const f32x4*)(Y + (size_t)tok * 512 + g * 16 + c);
            const u32x2 uw = *(const u32x2*)(U2 + ((size_t)g * NTOK + tok) * 16 + c);
            const f32x4 d = *(const f32x4*)(dskip + g * 16 + c);
            f32x4 y = acc[m][n] + yi; y[0] += d[0] * bflo(uw.x); y[1] += d[1] * bfhi(uw.x); y[2] += d[2] * bflo(uw.y); y[3] += d[3] * bfhi(uw.y);
            f32x4 o; o[0] = gelu_tanh(y[0]); o[1] = gelu_tanh(y[1]); o[2] = gelu_tanh(y[2]); o[3] = gelu_tanh(y[3]);
            st4bf(YG + (size_t)tok * 512 + g * 16 + c, o); }
    }
};
__device__ __forceinline__ void ssq_add(float s, float* dst, int fq) { s += SHX(s, 16); s = sh32_sum(s); if (fq == 0) atomicAdd(dst, s); }
struct EGlu {
    static constexpr bool HAS_MID = false;
    int mt, nt; const bf16_t* YG; bf16_t* YCAT; float* ssq;
    __device__ __forceinline__ void operator()(f32x4 (&acc)[4][4], int wr, int wc, int fr, int fq) {
#pragma unroll
        for (int m = 0; m < 4; ++m) { const int tok = mt * 128 + wr * 64 + m * 16 + fr; float s = 0.f;
#pragma unroll
            for (int n = 0; n < 4; ++n) { const int col = nt * 256 + wc * 64 + n * 16 + 4 * fq;
                const u32x2 yw = *(const u32x2*)(YG + (size_t)tok * 512 + col); const f32x4 a = acc[m][n];
                f32x4 o; o[0] = bflo(yw.x) / (1.0f + __expf(-a[0])); o[1] = bfhi(yw.x) / (1.0f + __expf(-a[1])); o[2] = bflo(yw.y) / (1.0f + __expf(-a[2])); o[3] = bfhi(yw.y) / (1.0f + __expf(-a[3]));
                s += (o[0] * o[0] + o[1] * o[1]) + (o[2] * o[2] + o[3] * o[3]);
                st4bf(YCAT + (size_t)tok * 1024 + col, o); }
            ssq_add(s, ssq + tok, fq); }
    }
};
struct EOut {
    static constexpr bool HAS_MID = true;
    int mt, nt; const float* X; float* H; bf16_t* HB; const float* ssq_ssm; float* ssq1;
    __device__ __forceinline__ void mid(int kt, f32x4 (&acc)[4][4], int wr, int fr) {
        if (kt == 7) {
#pragma unroll
            for (int m = 0; m < 4; ++m) { const int tok = mt * 128 + wr * 64 + m * 16 + fr; const float rs = rsqrtf(ssq_ssm[tok] * (1.0f / 512.0f) + EPS);
#pragma unroll
                for (int n = 0; n < 4; ++n) acc[m][n] = acc[m][n] * rs; }
        }
    }
    __device__ __forceinline__ void operator()(f32x4 (&acc)[4][4], int wr, int wc, int fr, int fq) {
#pragma unroll
        for (int m = 0; m < 4; ++m) { const int tok = mt * 128 + wr * 64 + m * 16 + fr; float s = 0.f;
#pragma unroll
            for (int n = 0; n < 4; ++n) { const int col = nt * 256 + wc * 64 + n * 16 + 4 * fq; const size_t o = (size_t)tok * 1024 + col;
                const f32x4 h = *(const f32x4*)(X + o) + acc[m][n];
                s += (h[0] * h[0] + h[1] * h[1]) + (h[2] * h[2] + h[3] * h[3]);
                *(f32x4*)(H + o) = h; st4bf(HB + o, h); }
            ssq_add(s, ssq1 + tok, fq); }
    }
};
struct ESoftmax {
    static constexpr bool HAS_MID = false;
    bf16_t* P; size_t ldc; LAS float* red;
    __device__ __forceinline__ void operator()(f32x4 (&acc)[4][4], int wr, int wc, int fr, int fq) {
        float mx[4];
#pragma unroll
        for (int m = 0; m < 4; ++m) { float v = -INFINITY;
#pragma unroll
            for (int n = 0; n < 4; ++n) v = fmaxf(fmaxf(v, fmaxf(acc[m][n][0], acc[m][n][1])), fmaxf(acc[m][n][2], acc[m][n][3]));
            v = fmaxf(v, SHX(v, 16)); v = sh32_max(v);
            if (fq == 0) red[(wr * 64 + m * 16 + fr) * 4 + wc] = v; mx[m] = v; }
        __syncthreads();
        float sm[4];
#pragma unroll
        for (int m = 0; m < 4; ++m) { const f32x4 q = *(const LAS f32x4*)(red + (wr * 64 + m * 16 + fr) * 4); const float mm = fmaxf(fmaxf(q[0], q[1]), fmaxf(q[2], q[3])); float s = 0.f;
#pragma unroll
            for (int n = 0; n < 4; ++n) { f32x4 p; p[0] = __builtin_amdgcn_exp2f(acc[m][n][0] - mm); p[1] = __builtin_amdgcn_exp2f(acc[m][n][1] - mm); p[2] = __builtin_amdgcn_exp2f(acc[m][n][2] - mm); p[3] = __builtin_amdgcn_exp2f(acc[m][n][3] - mm);
                acc[m][n] = p; s += (p[0] + p[1]) + (p[2] + p[3]); }
            s += SHX(s, 16); s = sh32_sum(s);
            if (fq == 0) red[512 + (wr * 64 + m * 16 + fr) * 4 + wc] = s; sm[m] = s; }
        __syncthreads();
#pragma unroll
        for (int m = 0; m < 4; ++m) { const int r = wr * 64 + m * 16 + fr; const f32x4 q = *(const LAS f32x4*)(red + 512 + r * 4); const float inv = 1.0f / ((q[0] + q[1]) + (q[2] + q[3]));
#pragma unroll
            for (int n = 0; n < 4; ++n) st4bf(P + (size_t)r * ldc + wc * 64 + n * 16 + 4 * fq, acc[m][n] * inv); }
    }
};
struct EWo {
    static constexpr bool HAS_MID = false;
    int mt, nt; float* H; bf16_t* HB; float* ssq2;
    __device__ __forceinline__ void operator()(f32x4 (&acc)[4][4], int wr, int wc, int fr, int fq) {
#pragma unroll
        for (int m = 0; m < 4; ++m) { const int tok = mt * 128 + wr * 64 + m * 16 + fr; float s = 0.f;
#pragma unroll
            for (int n = 0; n < 4; ++n) { const int col = nt * 256 + wc * 64 + n * 16 + 4 * fq; const size_t o = (size_t)tok * 1024 + col;
                const f32x4 h = *(const f32x4*)(H + o) + acc[m][n];
                s += (h[0] * h[0] + h[1] * h[1]) + (h[2] * h[2] + h[3] * h[3]);
                *(f32x4*)(H + o) = h; st4bf(HB + o, h); }
            ssq_add(s, ssq2 + tok, fq); }
    }
};
struct EGateUp {
    static constexpr bool HAS_MID = false;
    const int* aid;
    int tok0; const float* ssq2; const float* gw; bf16_t* HID; int ct;
    __device__ __forceinline__ void operator()(f32x4 (&acc)[4][4], int wr, int wc, int fr, int fq) {
#pragma unroll
        for (int m = 0; m < 4; ++m) { const int r = wr * 64 + m * 16 + fr; int tok = tok0 + r; float w = 1.0f;
            if (aid) { const int a = aid[r]; tok = a < 0 ? 0 : (a >> 3); w = a < 0 ? 0.f : gw[a]; }
            const float rs = rsqrtf(ssq2[tok] * (1.0f / 1024.0f) + EPS);
#pragma unroll
            for (int p = 0; p < 2; ++p) { const f32x4 gg = acc[m][2 * p] * rs, uu = acc[m][2 * p + 1] * rs; f32x4 o;
#pragma unroll
                for (int i = 0; i < 4; ++i) o[i] = w * (gg[i] / (1.0f + __expf(-gg[i]))) * uu[i];
                st4bf(HID + (size_t)r * 256 + ct * 128 + wc * 32 + p * 16 + 4 * fq, o); } }
    }
};
struct EDownY {
    static constexpr bool HAS_MID = false;
    const int* aid; int aid0; bf16_t* Y; int ct;
    __device__ __forceinline__ void operator()(f32x4 (&acc)[4][4], int wr, int wc, int fr, int fq) {
#pragma unroll
        for (int m = 0; m < 4; ++m) { const int r = wr * 64 + m * 16 + fr; const int a = aid[r];
            if (a >= 0) { bf16_t* p = Y + (size_t)(a - aid0) * 1024 + ct * 256 + wc * 64 + 4 * fq;
#pragma unroll
                for (int n = 0; n < 4; ++n) st4bf(p + n * 16, acc[m][n]); } }
    }
};
struct EDownAcc {
    static constexpr bool HAS_MID = false;
    int tok0; float* H; int ct;
    __device__ __forceinline__ void operator()(f32x4 (&acc)[4][4], int wr, int wc, int fr, int fq) {
#pragma unroll
        EPI_LOOP { float* p = H + (size_t)(tok0 + wr * 64 + m * 16 + fr) * 1024 + ct * 256 + wc * 64 + n * 16 + 4 * fq; *(f32x4*)p = *(const f32x4*)p + acc[m][n]; }
    }
};

constexpr int AT_K = 0, AT_V = 16384, AT_VSZ = 128 * 136, AT_WS = AT_V + 3 * AT_VSZ, AT_STG = 69632;
__device__ __forceinline__ int crow(int r, int hi) { return (r & 3) + 8 * (r >> 2) + 4 * hi; }

typedef __amdgpu_buffer_rsrc_t rsrc_t;
__device__ __forceinline__ u32x4 bld16(rsrc_t r, unsigned voff, unsigned soff) { return __builtin_bit_cast(u32x4, __builtin_amdgcn_raw_buffer_load_b128(r, (int)voff, (int)soff, 0)); }
__device__ __forceinline__ void bst16(rsrc_t r, u32x4 v, unsigned voff, unsigned soff) { __builtin_amdgcn_raw_buffer_store_b128(__builtin_bit_cast(__attribute__((ext_vector_type(4))) unsigned, v), r, (int)voff, (int)soff, 0); }

#ifndef PROBE_VAR
#define PROBE_VAR 0
#endif
template <int VAR>
__device__ __forceinline__ void attn_unit(LAS unsigned char* lds, rsrc_t wsr, int b, int h, int qb, float lam, const float* gsub, int bx) {
    int tid = threadIdx.x; asm volatile("" : "+v"(tid));
    const int lane = tid & 63, r32 = lane & 31, hi = lane >> 5;
    const int wid = __builtin_amdgcn_readfirstlane(tid >> 6);
    const int q0 = qb * 256 + wid * 32;
    const unsigned tokbase = (unsigned)b * SEQ;
    LAS float* wsc = (LAS float*)(lds + AT_WS) + wid * 32;
    const int sr = tid >> 3, sc = tid & 7;
    const unsigned kst = (unsigned)(sr * 128 + ((sc ^ ((sr >> 1) & 7)) << 4));
    const unsigned vst = (unsigned)(sr * 136 + sc * 16);
    const unsigned ksw = (unsigned)((r32 >> 1) & 7);
    const int nkt = 4 * qb + 4;
    const unsigned koff = (unsigned)(sr * 1024 + sc * 16), voff = (unsigned)(sr * (SEQ * 2) + sc * 16);
    const unsigned qoff = (unsigned)(r32 * 1024 + hi * 16);
    const unsigned s_o1 = (unsigned)WS_O1S + (unsigned)bx * (64u * 512u * 4u);
#pragma unroll 1
    for (int map = 0; map < 2; ++map) {
        const int mm = 2 * h + map;
        const unsigned s_q = (unsigned)WS_Q + ((tokbase + (unsigned)q0) * 512u + (unsigned)mm * 64u) * 2u;
        const unsigned s_k = (unsigned)WS_K + (tokbase * 512u + (unsigned)mm * 64u) * 2u;
        const unsigned s_v = (unsigned)WS_VT + ((unsigned)(b * 512 + h * 128) * (unsigned)SEQ) * 2u;
        bf16x8 qr[4];
#pragma unroll
        for (int s = 0; s < 4; ++s) qr[s] = __builtin_bit_cast(bf16x8, bld16(wsr, qoff + s * 32, s_q));
        f32x16 o[4];
#pragma unroll
        for (int d = 0; d < 4; ++d) o[d] = (f32x16){};
        float nmr = 0.f, lrun = 0.f;
        u32x4 rk = bld16(wsr, koff, s_k), rv0 = bld16(wsr, voff, s_v), rv1 = bld16(wsr, voff, s_v + 64u * SEQ * 2u);
        *(LAS u32x4*)(lds + AT_K + kst) = rk;
        *(LAS u32x2*)(lds + AT_V + vst) = (u32x2){rv0.x, rv0.y}; *(LAS u32x2*)(lds + AT_V + vst + 8) = (u32x2){rv0.z, rv0.w};
        *(LAS u32x2*)(lds + AT_V + vst + 64 * 136) = (u32x2){rv1.x, rv1.y}; *(LAS u32x2*)(lds + AT_V + vst + 64 * 136 + 8) = (u32x2){rv1.z, rv1.w};
        __syncthreads();
        bf16x8 pa[4];
#pragma unroll
        for (int i = 0; i < 4; ++i) pa[i] = (bf16x8){};
        auto H1 = [&](int kt) {
            const unsigned kb = AT_K + (unsigned)(kt & 1) * 8192u;
            f32x16 p0, p1;
#pragma unroll
            for (int r = 0; r < 16; ++r) { p0[r] = nmr; p1[r] = nmr; }
            { bf16x8 kf[8];
#pragma unroll
              for (int s = 0; s < 4; ++s) { const unsigned ch = ((unsigned)(2 * s + hi) ^ ksw) << 4;
                  kf[2 * s] = *(const LAS bf16x8*)(lds + kb + r32 * 128 + ch); kf[2 * s + 1] = *(const LAS bf16x8*)(lds + kb + (r32 + 32) * 128 + ch); }
              __builtin_amdgcn_sched_barrier(0);
#pragma unroll
              for (int s = 0; s < 4; ++s) { p0 = __builtin_amdgcn_mfma_f32_32x32x16_bf16(kf[2 * s], qr[s], p0, 0, 0, 0); p1 = __builtin_amdgcn_mfma_f32_32x32x16_bf16(kf[2 * s + 1], qr[s], p1, 0, 0, 0); } }
            if (kt * 64 + 63 > q0) {
                const int qpos = q0 + r32, kbase = kt * 64 + 4 * hi;
#pragma unroll
                for (int r = 0; r < 16; ++r) { const int key = kbase + (r & 3) + 8 * (r >> 2); if (key > qpos) p0[r] = -INFINITY; if (key + 32 > qpos) p1[r] = -INFINITY; }
            }
            float mx = __builtin_fmaxf(__builtin_fmaxf(p0[0], p1[0]), __builtin_fmaxf(p0[1], p1[1]));
#pragma unroll
            for (int r = 2; r < 16; r += 2) mx = __builtin_fmaxf(__builtin_fmaxf(mx, __builtin_fmaxf(p0[r], p1[r])), __builtin_fmaxf(p0[r + 1], p1[r + 1]));
            mx = sh32_max(mx);
            if (kt == 0 || __any(mx > 8.0f)) {
                const float dl = kt == 0 ? mx : fmaxf(mx, 0.f);
                const float alpha = __builtin_amdgcn_exp2f(-dl);
                nmr -= dl; lrun *= alpha;
#pragma unroll
                for (int r = 0; r < 16; ++r) { p0[r] -= dl; p1[r] -= dl; }
                if (hi == 0) wsc[r32] = alpha;
                LDS_WAIT();
#pragma unroll
                for (int g4 = 0; g4 < 4; ++g4) { const f32x4 a4 = *(const LAS f32x4*)(wsc + 8 * g4 + 4 * hi);
#pragma unroll
                    for (int d = 0; d < 4; ++d) { o[d][4 * g4] *= a4[0]; o[d][4 * g4 + 1] *= a4[1]; o[d][4 * g4 + 2] *= a4[2]; o[d][4 * g4 + 3] *= a4[3]; } }
            }
            float rsum = 0.f;
#pragma unroll
            for (int r = 0; r < 16; ++r) { if (VAR == 1) { p0[r] *= 0.5f; p1[r] *= 0.5f; } else { p0[r] = __builtin_amdgcn_exp2f(p0[r]); p1[r] = __builtin_amdgcn_exp2f(p1[r]); } rsum += p0[r] + p1[r]; }
            lrun += rsum;
            u32x4 w;
            w.x = pk2(p0[0], p0[1]); w.y = pk2(p0[2], p0[3]); w.z = pk2(p0[4], p0[5]); w.w = pk2(p0[6], p0[7]); pa[0] = __builtin_bit_cast(bf16x8, w);
            w.x = pk2(p0[8], p0[9]); w.y = pk2(p0[10], p0[11]); w.z = pk2(p0[12], p0[13]); w.w = pk2(p0[14], p0[15]); pa[1] = __builtin_bit_cast(bf16x8, w);
            w.x = pk2(p1[0], p1[1]); w.y = pk2(p1[2], p1[3]); w.z = pk2(p1[4], p1[5]); w.w = pk2(p1[6], p1[7]); pa[2] = __builtin_bit_cast(bf16x8, w);
            w.x = pk2(p1[8], p1[9]); w.y = pk2(p1[10], p1[11]); w.z = pk2(p1[12], p1[13]); w.w = pk2(p1[14], p1[15]); pa[3] = __builtin_bit_cast(bf16x8, w);
        };
        auto H2 = [&](int kt) {
            const unsigned vb = AT_V + (unsigned)(kt % 3) * (unsigned)AT_VSZ;
            u32x4 vf[2][4];
#define AT_VLOAD(buf, ks) _Pragma("unroll") for (int d = 0; d < 4; ++d) { const unsigned va = vb + (unsigned)((d * 32 + r32) * 136 + ((ks) * 16 + 4 * hi) * 2); \
                const u32x2 lo = *(const LAS u32x2*)(lds + va), hh = *(const LAS u32x2*)(lds + va + 16); vf[buf][d] = (u32x4){lo.x, lo.y, hh.x, hh.y}; }
            AT_VLOAD(0, 0)
            __builtin_amdgcn_sched_barrier(0);
#pragma unroll
            for (int ks = 0; ks < 4; ++ks) {
                if (ks == 0) { AT_VLOAD(1, 1) } else if (ks == 1) { AT_VLOAD(0, 2) } else if (ks == 2) { AT_VLOAD(1, 3) }
                __builtin_amdgcn_sched_barrier(0);
#pragma unroll
                for (int d = 0; d < 4; ++d) { if (VAR == 2) { o[d][0] += __uint_as_float(vf[ks & 1][d].x) + __uint_as_float(vf[ks & 1][d].z) + __builtin_bit_cast(f32x4, pa[ks])[0]; } else o[d] = __builtin_amdgcn_mfma_f32_32x32x16_bf16(pa[ks], __builtin_bit_cast(bf16x8, vf[ks & 1][d]), o[d], 0, 0, 0); }
                __builtin_amdgcn_sched_barrier(0);
            }
#undef AT_VLOAD
        };
        const bool lower = wid < 4 || VAR == 5;
#pragma unroll 1
        for (int kt = 0; kt < nkt; ++kt) {
            const bool more = kt + 1 < nkt;
            if (more && VAR != 4) { rk = bld16(wsr, koff, s_k + (unsigned)(kt + 1) * 65536u); rv0 = bld16(wsr, voff, s_v + (unsigned)(kt + 1) * 128u); rv1 = bld16(wsr, voff, s_v + 64u * SEQ * 2u + (unsigned)(kt + 1) * 128u); }
            if (!lower && kt > 0 && (kt - 1) * 64 <= q0 + 31) H2(kt - 1);
            if (kt * 64 <= q0 + 31) { H1(kt); if (lower) H2(kt); }
            if (more && VAR != 4) {
                const unsigned kbn = AT_K + 8192u - (unsigned)(kt & 1) * 8192u, vbn = AT_V + (unsigned)((kt + 1) % 3) * (unsigned)AT_VSZ;
                *(LAS u32x4*)(lds + kbn + kst) = rk;
                *(LAS u32x2*)(lds + vbn + vst) = (u32x2){rv0.x, rv0.y}; *(LAS u32x2*)(lds + vbn + vst + 8) = (u32x2){rv0.z, rv0.w};
                *(LAS u32x2*)(lds + vbn + vst + 64 * 136) = (u32x2){rv1.x, rv1.y}; *(LAS u32x2*)(lds + vbn + vst + 64 * 136 + 8) = (u32x2){rv1.z, rv1.w};
            }
            if (VAR != 3) __syncthreads();
        }
        if (!lower) { if ((nkt - 1) * 64 <= q0 + 31) H2(nkt - 1); }
        __syncthreads();
        float lt = sh32_sum(lrun);
        if (hi == 0) wsc[r32] = 1.0f / lt;
        LDS_WAIT();
#pragma unroll
        for (int g4 = 0; g4 < 4; ++g4) { const f32x4 a4 = *(const LAS f32x4*)(wsc + 8 * g4 + 4 * hi);
#pragma unroll
            for (int d = 0; d < 4; ++d) { o[d][4 * g4] *= a4[0]; o[d][4 * g4 + 1] *= a4[1]; o[d][4 * g4 + 2] *= a4[2]; o[d][4 * g4 + 3] *= a4[3]; } }
        LDS_WAIT();
        int tid2 = tid; asm volatile("" : "+v"(tid2));
        const unsigned soff1 = (unsigned)(tid2 * 256);
        if (map == 0) {
#pragma unroll
            for (int d = 0; d < 4; ++d)
#pragma unroll
                for (int g4 = 0; g4 < 4; ++g4) { const f32x4 t4 = (f32x4){o[d][4 * g4], o[d][4 * g4 + 1], o[d][4 * g4 + 2], o[d][4 * g4 + 3]}; bst16(wsr, __builtin_bit_cast(u32x4, t4), soff1 + (d * 64 + g4 * 16), s_o1); }
        } else {
            float ss[16];
#pragma unroll
            for (int r = 0; r < 16; ++r) ss[r] = 0.f;
#pragma unroll
            for (int d = 0; d < 4; ++d)
#pragma unroll
                for (int g4 = 0; g4 < 4; ++g4) { const f32x4 a = __builtin_bit_cast(f32x4, bld16(wsr, soff1 + (d * 64 + g4 * 16), s_o1));
#pragma unroll
                    for (int q = 0; q < 4; ++q) { const float v = a[q] - lam * o[d][4 * g4 + q]; o[d][4 * g4 + q] = v; ss[4 * g4 + q] += v * v; } }
#pragma unroll
            for (int r = 0; r < 16; ++r) { float s = ss[r]; s += SHX(s, 1); s += SHX(s, 2); s += SHX(s, 4); s += SHX(s, 8); s += SHX(s, 16);
                ss[r] = rsqrtf(s * (1.0f / 128.0f) + EPS) * (1.0f - LAMBDA_INIT); }
            LAS unsigned char* stg = lds + AT_STG + wid * (32 * 272);
#pragma unroll
            for (int d = 0; d < 4; ++d) { const int r32b = tid2 & 31, hib = (tid2 >> 5) & 1; const float gg = gsub[d * 32 + r32b];
#pragma unroll
                for (int r = 0; r < 16; ++r) { const int row = (r & 3) + 8 * (r >> 2) + 4 * hib;
                    *(LAS bf16_t*)(stg + row * 272 + (d * 32 + r32b) * 2) = (bf16_t)(pk2(o[d][r] * ss[r] * gg, 0.f) & 0xffffu); } }
            LDS_WAIT();
            const unsigned s_y = (unsigned)WS_YCAT + ((tokbase + (unsigned)q0) * 1024u + 512u + (unsigned)h * 128u) * 2u;
            const int lane2 = tid2 & 63;
            const unsigned yoff = (unsigned)((lane2 >> 4) * 2048 + (lane2 & 15) * 16);
#pragma unroll 2
            for (int i = 0; i < 8; ++i) { const int row = i * 4 + (lane2 >> 4), ch = lane2 & 15;
                const u32x4 v = *(const LAS u32x4*)(stg + row * 272 + ch * 16);
                if (VAR == 0) bst16(wsr, v, yoff, s_y + (unsigned)i * 8192u); }
            LDS_WAIT();
        }
    }
}


constexpr int AT2_V = 16384, AT2_WS = AT2_V + 2 * AT_VSZ, AT2_Q = 53248;
template <int VAR>
__device__ __forceinline__ void attn_unit2(LAS unsigned char* lds, rsrc_t wsr, int b, int h, int qb, float lam, const float* gsub, int bx) {
    int tid = threadIdx.x; asm volatile("" : "+v"(tid));
    const int lane = tid & 63, r32 = lane & 31, hi = lane >> 5;
    const int wid = __builtin_amdgcn_readfirstlane(tid >> 6);
    const int q0 = qb * 256 + wid * 32;
    const unsigned tokbase = (unsigned)b * SEQ;
    LAS float* wsc = (LAS float*)(lds + AT2_WS) + wid * 32;
    LAS unsigned char* qs = lds + AT2_Q + wid * 4096 + lane * 16;
    const int sr = tid >> 3, sc = tid & 7;
    const unsigned kst = (unsigned)(sr * 128 + ((sc ^ ((sr >> 1) & 7)) << 4));
    const unsigned vst = (unsigned)(sr * 136 + sc * 16);
    const unsigned ksw = (unsigned)((r32 >> 1) & 7);
    const int nkt = 4 * qb + 4;
    const unsigned koff = (unsigned)(sr * 1024 + sc * 16), voff = (unsigned)(sr * (SEQ * 2) + sc * 16);
    const unsigned qoff = (unsigned)(r32 * 1024 + hi * 16);
    const unsigned s_o1 = (unsigned)WS_O1S + (unsigned)bx * (64u * 512u * 4u);
#pragma unroll 1
    for (int map = 0; map < 2; ++map) {
        const int mm = 2 * h + map;
        const unsigned s_q = (unsigned)WS_Q + ((tokbase + (unsigned)q0) * 512u + (unsigned)mm * 64u) * 2u;
        const unsigned s_k = (unsigned)WS_K + (tokbase * 512u + (unsigned)mm * 64u) * 2u;
        const unsigned s_v = (unsigned)WS_VT + ((unsigned)(b * 512 + h * 128) * (unsigned)SEQ) * 2u;
#pragma unroll
        for (int s = 0; s < 4; ++s) *(LAS u32x4*)(qs + s * 1024) = bld16(wsr, qoff + s * 32, s_q);
        f32x16 o[4];
#pragma unroll
        for (int d = 0; d < 4; ++d) o[d] = (f32x16){};
        float nmr = 0.f, lrun = 0.f;
        u32x4 rk = bld16(wsr, koff, s_k), rv0 = bld16(wsr, voff, s_v), rv1 = bld16(wsr, voff, s_v + 64u * SEQ * 2u);
        *(LAS u32x4*)(lds + AT_K + kst) = rk;
        *(LAS u32x2*)(lds + AT2_V + vst) = (u32x2){rv0.x, rv0.y}; *(LAS u32x2*)(lds + AT2_V + vst + 8) = (u32x2){rv0.z, rv0.w};
        *(LAS u32x2*)(lds + AT2_V + vst + 64 * 136) = (u32x2){rv1.x, rv1.y}; *(LAS u32x2*)(lds + AT2_V + vst + 64 * 136 + 8) = (u32x2){rv1.z, rv1.w};
        rk = bld16(wsr, koff, s_k + 65536u);
        *(LAS u32x4*)(lds + AT_K + 8192 + kst) = rk;
        __syncthreads();
        auto SQK = [&](f32x16& p0, f32x16& p1, int kt) {
            const unsigned kb = AT_K + (unsigned)(kt & 1) * 8192u;
#pragma unroll
            for (int r = 0; r < 16; ++r) { p0[r] = nmr; p1[r] = nmr; }
            if (VAR == 4) return;
            bf16x8 kf[8], qf[4];
#pragma unroll
            for (int s = 0; s < 4; ++s) { const unsigned ch = ((unsigned)(2 * s + hi) ^ ksw) << 4;
                kf[2 * s] = *(const LAS bf16x8*)(lds + kb + r32 * 128 + ch); kf[2 * s + 1] = *(const LAS bf16x8*)(lds + kb + (r32 + 32) * 128 + ch); qf[s] = *(const LAS bf16x8*)(qs + s * 1024); }
            __builtin_amdgcn_sched_barrier(0);
#pragma unroll
            for (int s = 0; s < 4; ++s) { p0 = __builtin_amdgcn_mfma_f32_32x32x16_bf16(kf[2 * s], qf[s], p0, 0, 0, 0); p1 = __builtin_amdgcn_mfma_f32_32x32x16_bf16(kf[2 * s + 1], qf[s], p1, 0, 0, 0); }
        };
        bf16x8 pa[4];
        auto SMX = [&](f32x16& p0, f32x16& p1, f32x16& n0, f32x16& n1, int kt) {
            if (kt * 64 + 63 > q0) {
                const int qpos = q0 + r32, kbase = kt * 64 + 4 * hi;
#pragma unroll
                for (int r = 0; r < 16; ++r) { const int key = kbase + (r & 3) + 8 * (r >> 2); if (key > qpos) p0[r] = -INFINITY; if (key + 32 > qpos) p1[r] = -INFINITY; }
            }
            float mx = __builtin_fmaxf(__builtin_fmaxf(p0[0], p1[0]), __builtin_fmaxf(p0[1], p1[1]));
#pragma unroll
            for (int r = 2; r < 16; r += 2) mx = __builtin_fmaxf(__builtin_fmaxf(mx, __builtin_fmaxf(p0[r], p1[r])), __builtin_fmaxf(p0[r + 1], p1[r + 1]));
            mx = sh32_max(mx);
            if (kt == 0 || __any(mx > 8.0f)) {
                const float dl = kt == 0 ? mx : fmaxf(mx, 0.f);
                const float alpha = __builtin_amdgcn_exp2f(-dl);
                nmr -= dl; lrun *= alpha;
#pragma unroll
                for (int r = 0; r < 16; ++r) { p0[r] -= dl; p1[r] -= dl; n0[r] -= dl; n1[r] -= dl; }
                if (hi == 0) wsc[r32] = alpha;
                LDS_WAIT();
#pragma unroll
                for (int g4 = 0; g4 < 4; ++g4) { const f32x4 a4 = *(const LAS f32x4*)(wsc + 8 * g4 + 4 * hi);
#pragma unroll
                    for (int d = 0; d < 4; ++d) { o[d][4 * g4] *= a4[0]; o[d][4 * g4 + 1] *= a4[1]; o[d][4 * g4 + 2] *= a4[2]; o[d][4 * g4 + 3] *= a4[3]; } }
            }
            float rsum = 0.f;
#pragma unroll
            for (int r = 0; r < 16; ++r) { if (VAR == 2) { p0[r] = p0[r] * 0.001f; p1[r] = p1[r] * 0.001f; } else { p0[r] = __builtin_amdgcn_exp2f(p0[r]); p1[r] = __builtin_amdgcn_exp2f(p1[r]); } rsum += p0[r] + p1[r]; }
            lrun += rsum;
            u32x4 w;
            w.x = pk2(p0[0], p0[1]); w.y = pk2(p0[2], p0[3]); w.z = pk2(p0[4], p0[5]); w.w = pk2(p0[6], p0[7]); pa[0] = __builtin_bit_cast(bf16x8, w);
            w.x = pk2(p0[8], p0[9]); w.y = pk2(p0[10], p0[11]); w.z = pk2(p0[12], p0[13]); w.w = pk2(p0[14], p0[15]); pa[1] = __builtin_bit_cast(bf16x8, w);
            w.x = pk2(p1[0], p1[1]); w.y = pk2(p1[2], p1[3]); w.z = pk2(p1[4], p1[5]); w.w = pk2(p1[6], p1[7]); pa[2] = __builtin_bit_cast(bf16x8, w);
            w.x = pk2(p1[8], p1[9]); w.y = pk2(p1[10], p1[11]); w.z = pk2(p1[12], p1[13]); w.w = pk2(p1[14], p1[15]); pa[3] = __builtin_bit_cast(bf16x8, w);
        };
        auto SPV = [&](int kt) {
            const unsigned vb = AT2_V + (unsigned)(kt & 1) * (unsigned)AT_VSZ;
            u32x4 vf[2][4];
#define AT_VLOAD(buf, ks) _Pragma("unroll") for (int d = 0; d < 4; ++d) { const unsigned va = vb + (unsigned)((d * 32 + r32) * 136 + ((ks) * 16 + 4 * hi) * 2); \
                const u32x2 lo = *(const LAS u32x2*)(lds + va), hh = *(const LAS u32x2*)(lds + va + 16); vf[buf][d] = (u32x4){lo.x, lo.y, hh.x, hh.y}; }
            AT_VLOAD(0, 0)
            __builtin_amdgcn_sched_barrier(0);
#pragma unroll
            for (int ks = 0; ks < 4; ++ks) {
                if (ks == 0) { AT_VLOAD(1, 1) } else if (ks == 1) { AT_VLOAD(0, 2) } else if (ks == 2) { AT_VLOAD(1, 3) }
                __builtin_amdgcn_sched_barrier(0);
#pragma unroll
                for (int d = 0; d < 4; ++d) o[d] = __builtin_amdgcn_mfma_f32_32x32x16_bf16(pa[ks], __builtin_bit_cast(bf16x8, vf[ks & 1][d]), o[d], 0, 0, 0);
                __builtin_amdgcn_sched_barrier(0);
            }
#undef AT_VLOAD
        };
        f32x16 pA0, pA1, pB0, pB1;
        SQK(pA0, pA1, 0);
#pragma unroll
        for (int r = 0; r < 16; ++r) { pB0[r] = 0.f; pB1[r] = 0.f; }
#define AT_STEP(P0, P1, N0, N1, kt) do { \
            const bool more1 = (kt) + 1 < nkt, more2 = (kt) + 2 < nkt; \
            if (more2) rk = bld16(wsr, koff, s_k + (unsigned)((kt) + 2) * 65536u); \
            if (more1) { rv0 = bld16(wsr, voff, s_v + (unsigned)((kt) + 1) * 128u); rv1 = bld16(wsr, voff, s_v + 64u * SEQ * 2u + (unsigned)((kt) + 1) * 128u); } \
            if ((kt) * 64 <= q0 + 31) { if (VAR != 5) SMX(P0, P1, N0, N1, (kt)); } \
            asm volatile("s_barrier" ::: "memory");        \
            if ((kt) * 64 <= q0 + 31) { if (VAR != 3) SPV(kt); } \
            if (more1 && ((kt) + 1) * 64 <= q0 + 31) SQK(N0, N1, (kt) + 1); \
            if (more2) *(LAS u32x4*)(lds + AT_K + (unsigned)((kt) & 1) * 8192u + kst) = rk; \
            if (more1) { const unsigned vbn = AT2_V + (unsigned)(((kt) + 1) & 1) * (unsigned)AT_VSZ; \
                *(LAS u32x2*)(lds + vbn + vst) = (u32x2){rv0.x, rv0.y}; *(LAS u32x2*)(lds + vbn + vst + 8) = (u32x2){rv0.z, rv0.w}; \
                *(LAS u32x2*)(lds + vbn + vst + 64 * 136) = (u32x2){rv1.x, rv1.y}; *(LAS u32x2*)(lds + vbn + vst + 64 * 136 + 8) = (u32x2){rv1.z, rv1.w}; } \
            __syncthreads(); } while (0)
        if (wid >= 4) asm volatile("s_barrier" ::: "memory");
#pragma unroll 1
        for (int kt = 0; kt < nkt; kt += 2) { AT_STEP(pA0, pA1, pB0, pB1, kt); AT_STEP(pB0, pB1, pA0, pA1, kt + 1); }
        if (wid < 4) asm volatile("s_barrier" ::: "memory");
#undef AT_STEP
        float lt = sh32_sum(lrun);
        if (hi == 0) wsc[r32] = 1.0f / lt;
        LDS_WAIT();
#pragma unroll
        for (int g4 = 0; g4 < 4; ++g4) { const f32x4 a4 = *(const LAS f32x4*)(wsc + 8 * g4 + 4 * hi);
#pragma unroll
            for (int d = 0; d < 4; ++d) { o[d][4 * g4] *= a4[0]; o[d][4 * g4 + 1] *= a4[1]; o[d][4 * g4 + 2] *= a4[2]; o[d][4 * g4 + 3] *= a4[3]; } }
        LDS_WAIT();
        int tid2 = tid; asm volatile("" : "+v"(tid2));
        const unsigned soff1 = (unsigned)(tid2 * 256);
        if (map == 0) {
#pragma unroll
            for (int d = 0; d < 4; ++d)
#pragma unroll
                for (int g4 = 0; g4 < 4; ++g4) { const f32x4 t4 = (f32x4){o[d][4 * g4], o[d][4 * g4 + 1], o[d][4 * g4 + 2], o[d][4 * g4 + 3]}; bst16(wsr, __builtin_bit_cast(u32x4, t4), soff1 + (d * 64 + g4 * 16), s_o1); }
        } else {
            float ss[16];
#pragma unroll
            for (int r = 0; r < 16; ++r) ss[r] = 0.f;
#pragma unroll
            for (int d = 0; d < 4; ++d)
#pragma unroll
                for (int g4 = 0; g4 < 4; ++g4) { const f32x4 a = __builtin_bit_cast(f32x4, bld16(wsr, soff1 + (d * 64 + g4 * 16), s_o1));
#pragma unroll
                    for (int q = 0; q < 4; ++q) { const float v = a[q] - lam * o[d][4 * g4 + q]; o[d][4 * g4 + q] = v; ss[4 * g4 + q] += v * v; } }
#pragma unroll
            for (int r = 0; r < 16; ++r) { float s = ss[r]; s += SHX(s, 1); s += SHX(s, 2); s += SHX(s, 4); s += SHX(s, 8); s += SHX(s, 16);
                ss[r] = rsqrtf(s * (1.0f / 128.0f) + EPS) * (1.0f - LAMBDA_INIT); }
            LAS unsigned char* stg = lds + AT2_Q + wid * (32 * 272);
#pragma unroll
            for (int d = 0; d < 4; ++d) { const int r32b = tid2 & 31, hib = (tid2 >> 5) & 1; const float gg = gsub[d * 32 + r32b];
#pragma unroll
                for (int r = 0; r < 16; ++r) { const int row = (r & 3) + 8 * (r >> 2) + 4 * hib;
                    *(LAS bf16_t*)(stg + row * 272 + (d * 32 + r32b) * 2) = (bf16_t)(pk2(o[d][r] * ss[r] * gg, 0.f) & 0xffffu); } }
            LDS_WAIT();
            const unsigned s_y = (unsigned)WS_YCAT + ((tokbase + (unsigned)q0) * 1024u + 512u + (unsigned)h * 128u) * 2u;
            const int lane2 = tid2 & 63;
            const unsigned yoff = (unsigned)((lane2 >> 4) * 2048 + (lane2 & 15) * 16);
#pragma unroll 2
            for (int i = 0; i < 8; ++i) { const int row = i * 4 + (lane2 >> 4), ch = lane2 & 15;
                const u32x4 v = *(const LAS u32x4*)(stg + row * 272 + ch * 16);
                if (VAR == 0) bst16(wsr, v, yoff, s_y + (unsigned)i * 8192u); }
            LDS_WAIT();
            __syncthreads();
        }
    }
}

constexpr int A3_K = 0, A3_V = 4 * 8192, A3_SV = 16384, A3_WS = A3_V + 3 * A3_SV, A3_QS = A3_WS + 2048;
typedef __attribute__((address_space(3))) const char* lds_cptr;
typedef short s16x4 __attribute__((ext_vector_type(4)));
__device__ __forceinline__ void glds16s(const void* sbase, unsigned voff, unsigned lds_dst) { unsigned keep;
    asm volatile("s_mov_b32 %0, m0\n\ts_mov_b32 m0, %3\n\ts_nop 0\n\tglobal_load_lds_dwordx4 %1, %2\n\ts_mov_b32 m0, %0" : "=&s"(keep) : "v"(voff), "s"(sbase), "s"(lds_dst) : "memory"); }
__device__ __forceinline__ s16x4 vtr(lds_cptr p) { return __builtin_bit_cast(s16x4, __builtin_amdgcn_ds_read_tr16_b64_v4i16((__attribute__((address_space(3))) s16x4*)p)); }
__device__ __forceinline__ bf16x8 kld(lds_cptr p) { return *(const __attribute__((address_space(3))) bf16x8*)p; }
#define A3_MX3(a, b, c) __builtin_fmaxf(__builtin_fmaxf((a), (b)), (c))
__device__ __forceinline__ float a3_rowmax(const f32x16& p0, const f32x16& p1) {
    float a = A3_MX3(p0[0], p0[1], p1[0]), b = A3_MX3(p0[2], p0[3], p1[1]); a = A3_MX3(a, p1[2], p1[3]);
#pragma unroll
    for (int r = 4; r < 16; r += 4) { a = A3_MX3(a, p0[r], p0[r + 1]); b = A3_MX3(b, p0[r + 2], p0[r + 3]); a = A3_MX3(a, p1[r], p1[r + 1]); b = A3_MX3(b, p1[r + 2], p1[r + 3]); }
    return sh32_max(__builtin_fmaxf(a, b)); }
__device__ __forceinline__ void a3_cmask(f32x16& p0, f32x16& p1, int jb, int qrel, int hi) {
    const int kb = 64 * jb + 4 * hi;
#pragma unroll
    for (int r = 0; r < 16; ++r) { const int kv = kb + (r & 3) + 8 * (r >> 2); if (kv > qrel) p0[r] = -INFINITY; if (kv + 32 > qrel) p1[r] = -INFINITY; } }
#ifndef A3_THR
#define A3_THR 8.0f
#endif
#define A3_SBAR() __builtin_amdgcn_sched_barrier(0)
#define A3_PIN(x) asm volatile("" : "+v"(x))
#define A3_MFMA(a, b, c) __builtin_amdgcn_mfma_f32_32x32x16_bf16(a, b, c, 0, 0, 0)
#define A3_WAIT_BAR(N) asm volatile("s_waitcnt vmcnt(" #N ") lgkmcnt(0)\n\ts_barrier" ::: "memory")
template <int VAR>
__device__ __forceinline__ void attn_unit3(LAS unsigned char* lds, rsrc_t wsr, const unsigned char* ws, int b, int h, int qb, float lam, const float* gsub, int bx) {
    int tid = threadIdx.x; asm volatile("" : "+v"(tid));
    const int lane = tid & 63, r32 = lane & 31, hi = lane >> 5;
    const int wid = __builtin_amdgcn_readfirstlane(tid >> 6);
    const int q0 = qb * 256 + wid * 32, NT = 4 * qb + 4, qrel = wid * 32 + r32;
    const unsigned tokbase = (unsigned)b * SEQ;
    const unsigned lds0 = (unsigned)(size_t)lds;
    LAS float* wsf = (LAS float*)(lds + A3_WS) + wid * 64;
    const lds_cptr kp0 = (lds_cptr)lds + A3_K + hi * 1024 + r32 * 16;
    const lds_cptr vp0 = (lds_cptr)lds + A3_V + ((lane >> 4) & 1) * 32 + (lane & 3) * 8 + (4 * hi + ((lane & 15) >> 2)) * 64;
    const unsigned kvo = (unsigned)(lane * 1024 + wid * 16);
    const unsigned vvo = (unsigned)(((16 * (wid & 3) + (lane >> 2)) * 512 + (wid >> 2) * 32 + (lane & 3) * 8) * 2);
    const unsigned kdst = lds0 + A3_K + wid * 1024, vdst = lds0 + A3_V + wid * 1024;
    const unsigned qoff = (unsigned)(r32 * 1024 + hi * 16);
    const lds_cptr qs = (lds_cptr)lds + A3_QS + wid * 4096 + lane * 16;
    const unsigned s_o1 = (unsigned)WS_O1S + (unsigned)bx * (64u * 512u * 4u);
#pragma unroll 1
    for (int map = 0; map < 2; ++map) {
        const int mm = 2 * h + map;
        const unsigned char* Kg = ws + WS_K + ((size_t)tokbase * 512 + (size_t)mm * 64) * 2;
        const unsigned char* Vg = ws + WS_VT + ((size_t)tokbase * 512 + (size_t)h * 128) * 2;
        const unsigned s_q = (unsigned)WS_Q + ((tokbase + (unsigned)q0) * 512u + (unsigned)mm * 64u) * 2u;
#define DMA_K(t) glds16s(Kg + (size_t)(t) * 65536, kvo, (unsigned)__builtin_amdgcn_readfirstlane(kdst + (unsigned)((t) & 3) * 8192u))
#define DMA_V(t, slot) do { glds16s(Vg + (size_t)(t) * 65536, vvo, (unsigned)__builtin_amdgcn_readfirstlane(vdst + (unsigned)(slot))); \
                            glds16s(Vg + (size_t)(t) * 65536 + 128, vvo, (unsigned)__builtin_amdgcn_readfirstlane(vdst + (unsigned)(slot) + 8192u)); } while (0)
        DMA_K(0); DMA_V(0, 0); DMA_K(1); DMA_K(2);
        bf16x8 qa, qb;
        { u32x4 q4[4];
#pragma unroll
          for (int d0 = 0; d0 < 4; ++d0) q4[d0] = bld16(wsr, qoff + d0 * 32, s_q);
#pragma unroll
          for (int d0 = 0; d0 < 4; ++d0) *(LAS u32x4*)((LAS unsigned char*)qs + d0 * 1024) = q4[d0]; }
        float mhat = 0.f, l_reg = 0.f; f32x16 o[4];
#pragma unroll
        for (int d = 0; d < 4; ++d) o[d] = (f32x16){};
        f32x16 negm = (f32x16){}; A3_PIN(negm);
        bool resc = false;
        f32x16 pA0, pA1, pB0, pB1; bf16x8 kfa, kfb, kfc, kfd; s16x4 vlo[4], vhi[4]; u32x4 pw0, pw1, pw2, pw3;
        int sl_prev = 0, sl_cur = 0, sl_next = A3_SV;
#define ROT() do { sl_prev = sl_cur; sl_cur = sl_next; sl_next = (sl_next == 2 * A3_SV) ? 0 : sl_next + A3_SV; } while (0)
#define RESC() do { if (resc) { _Pragma("unroll") for (int d_ = 0; d_ < 4; ++d_) _Pragma("unroll") for (int r = 0; r < 16; ++r) o[d_][r] *= wsf[(r & 3) + 8 * (r >> 2) + 4 * hi]; } } while (0)
        A3_WAIT_BAR(0);
        { bf16x8 k8[8], qr[4];
#pragma unroll
          for (int d0 = 0; d0 < 4; ++d0) { k8[2 * d0] = kld(kp0 + d0 * 2048); k8[2 * d0 + 1] = kld(kp0 + d0 * 2048 + 512); qr[d0] = kld(qs + d0 * 1024); }
          pA0 = A3_MFMA(k8[0], qr[0], negm); pA1 = A3_MFMA(k8[1], qr[0], negm); pA0 = A3_MFMA(k8[2], qr[1], pA0); pA1 = A3_MFMA(k8[3], qr[1], pA1);
          pA0 = A3_MFMA(k8[4], qr[2], pA0); pA1 = A3_MFMA(k8[5], qr[2], pA1); pA0 = A3_MFMA(k8[6], qr[3], pA0); pA1 = A3_MFMA(k8[7], qr[3], pA1); }
        if (NT == 4) a3_cmask(pA0, pA1, 0, qrel, hi);
        { const float rm = a3_rowmax(pA0, pA1); mhat = rm;
#pragma unroll
          for (int r = 0; r < 16; ++r) { pA0[r] = __builtin_amdgcn_exp2f(pA0[r] - rm); pA1[r] = __builtin_amdgcn_exp2f(pA1[r] - rm); negm[r] = -rm; }
          A3_PIN(negm); }
        A3_WAIT_BAR(0);
        DMA_K(3); DMA_V(1, A3_SV); ROT();
        kfa = kld(kp0 + 8192); kfb = kld(kp0 + 8192 + 512); kfc = kld(kp0 + 8192 + 2048); kfd = kld(kp0 + 8192 + 2560);
        qa = kld(qs); qb = kld(qs + 1024);
#define PKW(P, i) pk2(P[i], P[(i) + 1])
#define PAF(k) __builtin_bit_cast(bf16x8, pw##k)
#define VFR(i) (bf16x8){vlo[i][0], vlo[i][1], vlo[i][2], vlo[i][3], vhi[i][0], vhi[i][1], vhi[i][2], vhi[i][3]}
#define VRD(sl, j) do { vlo[sl] = vtr(vp_ + (((j) & 3) * 4096 + ((j) >> 2) * 1024)); vhi[sl] = vtr(vp_ + (((j) & 3) * 4096 + ((j) >> 2) * 1024 + 512)); } while (0)
#define FO(f) (((f) >> 1) * 2048 + ((f) & 1) * 512)
#define GAPA(VR, MF, KF, QF, a0, a1, a2, a3, W0, W1, PW) do { VR; A3_SBAR(); MF; KF; QF; sacc += a0; sacc += a1; sacc += a2; sacc += a3; W0; W1; A3_PIN(PW); A3_PIN(sacc); A3_SBAR(); } while (0)
#define GAPB(MF, VR, X, i) do { MF; VR; X[i] = __builtin_amdgcn_exp2f(X[i]); X[(i) + 1] = __builtin_amdgcn_exp2f(X[(i) + 1]); A3_PIN(X); A3_SBAR(); } while (0)
#define STEP(C0, C1, P0, P1, t, MASK, GK, GV, GL) do { A3_SBAR(); \
        const lds_cptr vp_ = vp0 + sl_prev; const lds_cptr kc_ = kp0 + ((t) & 3) * 8192, kn_ = kp0 + (((t) + 1) & 3) * 8192; \
        float sacc = P0[0] + P0[1]; \
        GAPA((void)0,   C0 = A3_MFMA(kfa, qa, negm), kfa = kld(kc_ + FO(4)), (void)0,              P0[2], P0[3], P0[4], P0[5],     pw0[0] = PKW(P0, 0),  pw0[1] = PKW(P0, 2),  pw0); \
        GAPA((void)0,   C1 = A3_MFMA(kfb, qa, negm), kfb = kld(kc_ + FO(5)), qa = kld(qs + 2048),  P0[6], P0[7], P0[8], P0[9],     pw0[2] = PKW(P0, 4),  pw0[3] = PKW(P0, 6),  pw0); \
        GAPA((void)0,   C0 = A3_MFMA(kfc, qb, C0),   kfc = kld(kc_ + FO(6)), (void)0,              P0[10], P0[11], P0[12], P0[13], pw1[0] = PKW(P0, 8),  pw1[1] = PKW(P0, 10), pw1); \
        GAPA((void)0,   C1 = A3_MFMA(kfd, qb, C1),   kfd = kld(kc_ + FO(7)), qb = kld(qs + 3072),  P0[14], P0[15], P1[0], P1[1],   pw1[2] = PKW(P0, 12), pw1[3] = PKW(P0, 14), pw1); \
        GAPA(VRD(0, 0), C0 = A3_MFMA(kfa, qa, C0),   if (GL) kfa = kld(kn_ + FO(0)), (void)0,      P1[2], P1[3], P1[4], P1[5],     pw2[0] = PKW(P1, 0),  pw2[1] = PKW(P1, 2),  pw2); \
        GAPA(VRD(1, 1), C1 = A3_MFMA(kfb, qa, C1),   if (GL) kfb = kld(kn_ + FO(1)), if (GL) qa = kld(qs),        P1[6], P1[7], P1[8], P1[9],     pw2[2] = PKW(P1, 4),  pw2[3] = PKW(P1, 6),  pw2); \
        GAPA(VRD(2, 2), C0 = A3_MFMA(kfc, qb, C0),   if (GL) kfc = kld(kn_ + FO(2)), (void)0,      P1[10], P1[11], P1[12], P1[13], pw3[0] = PKW(P1, 8),  pw3[1] = PKW(P1, 10), pw3); \
        GAPA(VRD(3, 3), C1 = A3_MFMA(kfd, qb, C1),   if (GL) kfd = kld(kn_ + FO(3)), if (GL) qb = kld(qs + 1024), P1[14], P1[15], 0.f, 0.f,       pw3[2] = PKW(P1, 12), pw3[3] = PKW(P1, 14), pw3); \
        l_reg += sacc; \
        if (GK) DMA_K((t) + 3); if (GV) DMA_V((t) + 1, sl_next); \
        if (MASK) { const int jb_ = (t) - (NT - 4); if (jb_ >= 0) a3_cmask(C0, C1, jb_, qrel, hi); } \
        { const float rm = a3_rowmax(C0, C1); resc = false; \
          if (__builtin_expect(__any(rm > A3_THR), 0)) { const float dl = __builtin_fmaxf(rm, 0.f); mhat += dl; \
              _Pragma("unroll") for (int r = 0; r < 16; ++r) { C0[r] -= dl; C1[r] -= dl; negm[r] = -mhat; } \
              A3_PIN(negm); const float f = __builtin_amdgcn_exp2f(-dl); l_reg *= f; if (hi == 0) wsf[r32] = f; resc = true; } } \
        A3_SBAR(); \
        GAPB(o[0] = A3_MFMA(PAF(0), VFR(0), o[0]), VRD(0, 4),  C0, 0);  GAPB(o[1] = A3_MFMA(PAF(0), VFR(1), o[1]), VRD(1, 5),  C0, 2); \
        GAPB(o[2] = A3_MFMA(PAF(0), VFR(2), o[2]), VRD(2, 6),  C0, 4);  GAPB(o[3] = A3_MFMA(PAF(0), VFR(3), o[3]), VRD(3, 7),  C0, 6); \
        GAPB(o[0] = A3_MFMA(PAF(1), VFR(0), o[0]), VRD(0, 8),  C0, 8);  GAPB(o[1] = A3_MFMA(PAF(1), VFR(1), o[1]), VRD(1, 9),  C0, 10); \
        GAPB(o[2] = A3_MFMA(PAF(1), VFR(2), o[2]), VRD(2, 10), C0, 12); GAPB(o[3] = A3_MFMA(PAF(1), VFR(3), o[3]), VRD(3, 11), C0, 14); \
        GAPB(o[0] = A3_MFMA(PAF(2), VFR(0), o[0]), VRD(0, 12), C1, 0);  GAPB(o[1] = A3_MFMA(PAF(2), VFR(1), o[1]), VRD(1, 13), C1, 2); \
        GAPB(o[2] = A3_MFMA(PAF(2), VFR(2), o[2]), VRD(2, 14), C1, 4);  GAPB(o[3] = A3_MFMA(PAF(2), VFR(3), o[3]), VRD(3, 15), C1, 6); \
        GAPB(o[0] = A3_MFMA(PAF(3), VFR(0), o[0]), (void)0, C1, 8);     GAPB(o[1] = A3_MFMA(PAF(3), VFR(1), o[1]), (void)0, C1, 10); \
        GAPB(o[2] = A3_MFMA(PAF(3), VFR(2), o[2]), (void)0, C1, 12);    GAPB(o[3] = A3_MFMA(PAF(3), VFR(3), o[3]), (void)0, C1, 14); \
        } while (0)
        int t = 1;
#pragma unroll 1
        for (; t + 5 < NT; t += 2) {
            STEP(pB0, pB1, pA0, pA1, t, false, true, true, true);     A3_WAIT_BAR(3); RESC(); ROT();
            STEP(pA0, pA1, pB0, pB1, t + 1, false, true, true, true); A3_WAIT_BAR(3); RESC(); ROT();
        }
#define ENDW(tt) do { if ((tt) + 3 < NT) { A3_WAIT_BAR(3); } else if ((tt) + 2 < NT) { A3_WAIT_BAR(2); } else { A3_WAIT_BAR(0); } } while (0)
#pragma unroll 1
        for (; t + 1 < NT; t += 2) {
            STEP(pB0, pB1, pA0, pA1, t, true, (t + 3 < NT), (t + 1 < NT), (t + 1 < NT));         ENDW(t);     RESC(); ROT();
            STEP(pA0, pA1, pB0, pB1, t + 1, true, (t + 4 < NT), (t + 2 < NT), (t + 2 < NT));     ENDW(t + 1); RESC(); ROT();
        }
        STEP(pB0, pB1, pA0, pA1, NT - 1, true, false, false, false); RESC();
        { float sacc = pB0[0] + pB0[1];
#pragma unroll
          for (int r = 2; r < 16; ++r) sacc += pB0[r];
#pragma unroll
          for (int r = 0; r < 16; ++r) sacc += pB1[r];
          l_reg += sacc;
          pw0 = (u32x4){PKW(pB0, 0), PKW(pB0, 2), PKW(pB0, 4), PKW(pB0, 6)}; pw1 = (u32x4){PKW(pB0, 8), PKW(pB0, 10), PKW(pB0, 12), PKW(pB0, 14)};
          pw2 = (u32x4){PKW(pB1, 0), PKW(pB1, 2), PKW(pB1, 4), PKW(pB1, 6)}; pw3 = (u32x4){PKW(pB1, 8), PKW(pB1, 10), PKW(pB1, 12), PKW(pB1, 14)};
          const lds_cptr vp_ = vp0 + sl_cur;
#pragma unroll
          for (int ks = 0; ks < 4; ++ks) {
#pragma unroll
              for (int d = 0; d < 4; ++d) VRD(d, ks * 4 + d);
              const bf16x8 pf = ks == 0 ? PAF(0) : ks == 1 ? PAF(1) : ks == 2 ? PAF(2) : PAF(3);
#pragma unroll
              for (int d = 0; d < 4; ++d) o[d] = A3_MFMA(pf, VFR(d), o[d]);
              A3_SBAR(); } }
        asm volatile("s_waitcnt lgkmcnt(0)\n\ts_barrier" ::: "memory");
#undef DMA_K
#undef DMA_V
#undef ROT
#undef RESC
#undef PKW
#undef PAF
#undef VFR
#undef VRD
#undef FO
#undef GAPA
#undef GAPB
#undef STEP
#undef ENDW
        float lt = sh32_sum(l_reg);
        if (hi == 0) wsf[r32] = 1.0f / lt;
        LDS_WAIT();
#pragma unroll
        for (int g4 = 0; g4 < 4; ++g4) { const f32x4 a4 = *(const LAS f32x4*)(wsf + 8 * g4 + 4 * hi);
#pragma unroll
            for (int d = 0; d < 4; ++d) { o[d][4 * g4] *= a4[0]; o[d][4 * g4 + 1] *= a4[1]; o[d][4 * g4 + 2] *= a4[2]; o[d][4 * g4 + 3] *= a4[3]; } }
        LDS_WAIT();
        int tid2 = tid; asm volatile("" : "+v"(tid2));
        const unsigned soff1 = (unsigned)(tid2 * 256);
        if (map == 0) {
#pragma unroll
            for (int d = 0; d < 4; ++d)
#pragma unroll
                for (int g4 = 0; g4 < 4; ++g4) { const f32x4 t4 = (f32x4){o[d][4 * g4], o[d][4 * g4 + 1], o[d][4 * g4 + 2], o[d][4 * g4 + 3]}; bst16(wsr, __builtin_bit_cast(u32x4, t4), soff1 + (d * 64 + g4 * 16), s_o1); }
        } else {
            float ss[16];
#pragma unroll
            for (int r = 0; r < 16; ++r) ss[r] = 0.f;
#pragma unroll
            for (int d = 0; d < 4; ++d)
#pragma unroll
                for (int g4 = 0; g4 < 4; ++g4) { const f32x4 a = __builtin_bit_cast(f32x4, bld16(wsr, soff1 + (d * 64 + g4 * 16), s_o1));
#pragma unroll
                    for (int q = 0; q < 4; ++q) { const float v = a[q] - lam * o[d][4 * g4 + q]; o[d][4 * g4 + q] = v; ss[4 * g4 + q] += v * v; } }
#pragma unroll
            for (int r = 0; r < 16; ++r) { float s = ss[r]; s += SHX(s, 1); s += SHX(s, 2); s += SHX(s, 4); s += SHX(s, 8); s += SHX(s, 16);
                ss[r] = rsqrtf(s * (1.0f / 128.0f) + EPS) * (1.0f - LAMBDA_INIT); }
            LAS unsigned char* stg = lds + wid * (32 * 272);
#pragma unroll
            for (int d = 0; d < 4; ++d) { const int r32b = tid2 & 31, hib = (tid2 >> 5) & 1; const float gg = gsub[d * 32 + r32b];
#pragma unroll
                for (int r = 0; r < 16; ++r) { const int row = (r & 3) + 8 * (r >> 2) + 4 * hib;
                    *(LAS bf16_t*)(stg + row * 272 + (d * 32 + r32b) * 2) = (bf16_t)(pk2(o[d][r] * ss[r] * gg, 0.f) & 0xffffu); } }
            LDS_WAIT();
            const unsigned s_y = (unsigned)WS_YCAT + ((tokbase + (unsigned)q0) * 1024u + 512u + (unsigned)h * 128u) * 2u;
            const int lane2 = tid2 & 63;
            const unsigned yoff = (unsigned)((lane2 >> 4) * 2048 + (lane2 & 15) * 16);
#pragma unroll 2
            for (int i = 0; i < 8; ++i) { const int row = i * 4 + (lane2 >> 4), ch = lane2 & 15;
                const u32x4 v = *(const LAS u32x4*)(stg + row * 272 + ch * 16);
                if (VAR == 0) bst16(wsr, v, yoff, s_y + (unsigned)i * 8192u); }
            LDS_WAIT();
            __syncthreads();
        }
    }
}


namespace pg8 {
constexpr int HTB = 128 * 64 * 2, STAGE_BYTES = 8 * HTB;
__device__ __forceinline__ int lds_byte(int r, int c) { const int st = (r >> 4) * 2 + (c >> 5), rr = r & 15, cc = c & 31, ob = rr * 64 + cc * 2; return st * 1024 + (ob ^ (((ob >> 9) & 1) << 5)); }
__device__ __forceinline__ void stage_rc(int b, int& R, int& C) { const int st = b / 1024, sb = b % 1024, swz = sb ^ (((sb >> 9) & 1) << 5); R = (st >> 1) * 16 + swz / 64; C = (st & 1) * 32 + (swz % 64) / 2; }
__device__ __forceinline__ int perm32(int rho) { const int n = rho >> 4, i = rho & 15; return 8 * (i >> 2) + 4 * n + (i & 3); }
struct Unit { int a, b, c, d; };
struct Off4 { unsigned h0i0, h0i1, h1i0, h1i1; };
typedef f32x4 Acc[2][2][4][2];

template <class Epi, class Src>
__device__ __forceinline__ void gemm_phase(LAS unsigned char* lds, const Src& S, Epi& E) {
    int tid = threadIdx.x; asm volatile("" : "+v"(tid));
    const int wid = __builtin_amdgcn_readfirstlane(tid >> 6), lane = tid & 63, wr = wid >> 2, wc = wid & 3, fr = lane & 15, fq = lane >> 4;
    const int nt = S.nt; const int bks = S.bks;
    int R[2], C[2], Rb[2][2];
#pragma unroll
    for (int i = 0; i < 2; ++i) { stage_rc(tid * 16 + i * 8192, R[i], C[i]);
#pragma unroll
        for (int h = 0; h < 2; ++h) Rb[h][i] = Epi::PERM == 2 ? (64 * (R[i] >> 5) + 16 * ((R[i] & 15) >> 2) + 8 * h + 4 * ((R[i] >> 4) & 1) + (R[i] & 3))
                                              : h * 128 + (Epi::PERM == 1 ? ((R[i] & ~31) + perm32(R[i] & 31)) : R[i]); }
    const Off4 vB = S.boff(Rb, C); Off4 oC, oN;
    const unsigned ldsw = (unsigned)wid * 1024u;
    const int aoff = lds_byte(wr * 64 + fr, fq * 8), boffl = lds_byte(wc * 32 + fr, fq * 8);
#define PG8_SA(b, h) (((b) * 2 + (h)) * pg8::HTB)
#define PG8_SB(b, h) ((4 + (b) * 2 + (h)) * pg8::HTB)
#define PG8_STAGE2(bufoff, ptr, o0, o1) do { \
        __builtin_amdgcn_global_load_lds((const unsigned*)((const char*)(ptr) + (o0)), (LAS unsigned*)(lds + (bufoff) + ldsw), 16, 0, 0); \
        __builtin_amdgcn_global_load_lds((const unsigned*)((const char*)(ptr) + (o1)), (LAS unsigned*)(lds + (bufoff) + ldsw + 8192), 16, 0, 0); } while (0)
#define PG8_STAGE_A(bufoff, ptr, off, h) PG8_STAGE2(bufoff, ptr, (h) ? (off).h1i0 : (off).h0i0, (h) ? (off).h1i1 : (off).h0i1)
#define PG8_STAGE_B(bufoff, ptr, h) PG8_STAGE2(bufoff, ptr, (h) ? vB.h1i0 : vB.h0i0, (h) ? vB.h1i1 : vB.h0i1)
#define PG8_LDA(dst, b, h) do { _Pragma("unroll") for (int m = 0; m < 4; ++m) _Pragma("unroll") for (int k = 0; k < 2; ++k) dst[m][k] = *(const LAS bf16x8*)(lds + PG8_SA(b, h) + aoff + m * 2048 + k * 1024); } while (0)
#define PG8_LDB(dst, b, h) do { _Pragma("unroll") for (int n = 0; n < 2; ++n) _Pragma("unroll") for (int k = 0; k < 2; ++k) dst[n][k] = *(const LAS bf16x8*)(lds + PG8_SB(b, h) + boffl + n * 2048 + k * 1024); } while (0)
#define PG8_MMA(ai, bj, At, Bt) do { __builtin_amdgcn_s_setprio(1); _Pragma("unroll") for (int m = 0; m < 4; ++m) _Pragma("unroll") for (int n = 0; n < 2; ++n) _Pragma("unroll") for (int k = 0; k < 2; ++k) \
        acc[ai][bj][m][n] = __builtin_amdgcn_mfma_f32_16x16x32_bf16(Bt[n][k], At[m][k], acc[ai][bj][m][n], 0, 0, 0); __builtin_amdgcn_s_setprio(0); } while (0)
#define PG8_WAIT_V(n) asm volatile("s_waitcnt vmcnt(" #n ")" ::: "memory")
#define PG8_WAIT_L(n) asm volatile("s_waitcnt lgkmcnt(" #n ")" ::: "memory")
#define PG8_BAR __builtin_amdgcn_s_barrier()
#define PG8_SCHED __builtin_amdgcn_sched_barrier(0)
    Unit cur, nxt; int ui = 0;
    if (!S.next(0, cur)) return;
    Acc acc;
#pragma unroll
    for (int a = 0; a < 2; ++a)
#pragma unroll
        for (int b = 0; b < 2; ++b)
#pragma unroll
            for (int m = 0; m < 4; ++m)
#pragma unroll
                for (int n = 0; n < 2; ++n) acc[a][b][m][n] = (f32x4){0.f, 0.f, 0.f, 0.f};
    bf16x8 At[4][2], B0[2][2], B1[2][2];
    oC = S.aoff(cur, R, C);
    const char* cA = S.abase(cur); const char* cB = S.bbase(cur);
    PG8_STAGE_B(PG8_SB(0, 0), cB, 0); PG8_STAGE_B(PG8_SB(0, 1), cB, 1); PG8_STAGE_A(PG8_SA(0, 0), cA, oC, 0); PG8_STAGE_A(PG8_SA(0, 1), cA, oC, 1);
    if (wr == 1) PG8_BAR;
    PG8_WAIT_V(2); PG8_BAR;
    PG8_STAGE_B(PG8_SB(1, 0), cB + bks, 0); PG8_STAGE_A(PG8_SA(1, 0), cA + 128, oC, 0); PG8_STAGE_B(PG8_SB(1, 1), cB + bks, 1);
    PG8_WAIT_V(6); PG8_BAR;
    for (;;) {
        const bool has_next = S.next(ui + 1, nxt);
        const char* nA = has_next ? S.abase(nxt) : cA; const char* nB = has_next ? S.bbase(nxt) : cB;
        oN = oC;
        if constexpr (Src::GATHER) { if (has_next) oN = S.aoff(nxt, R, C); }
        for (int t = 0; t < nt; t += 2) {
            const bool last = (t == nt - 2);
            if constexpr (Epi::HAS_PRE) { if (last) { int fr2 = fr; asm volatile("" : "+v"(fr2)); E.pre(cur, wr, fr2); } }
            const char* a1 = cA + (size_t)(t + 1) * 128;
            const char* a2 = last ? nA : cA + (size_t)(t + 2) * 128; const char* b2 = last ? nB : cB + (ptrdiff_t)(t + 2) * bks;
            const char* a3 = a2 + 128; const char* b3 = b2 + bks;
            PG8_LDB(B0, 0, 0); PG8_LDB(B1, 0, 1); PG8_SCHED; PG8_LDA(At, 0, 0); PG8_STAGE_A(PG8_SA(1, 1), a1, oC, 1);
            if constexpr (Src::GATHER) { if (last) oC = oN; }
            PG8_WAIT_V(8); PG8_WAIT_L(0); PG8_BAR; PG8_MMA(0, 0, At, B0); PG8_MMA(0, 1, At, B1); PG8_BAR; PG8_SCHED;
            PG8_LDA(At, 0, 1); PG8_STAGE_B(PG8_SB(0, 0), b2, 0); PG8_STAGE_B(PG8_SB(0, 1), b2, 1); PG8_STAGE_A(PG8_SA(0, 0), a2, oC, 0);
            PG8_WAIT_V(8); PG8_WAIT_L(0); PG8_BAR; PG8_MMA(1, 0, At, B0); PG8_MMA(1, 1, At, B1); PG8_BAR; PG8_SCHED;
            PG8_LDB(B0, 1, 0); PG8_LDB(B1, 1, 1); PG8_SCHED; PG8_LDA(At, 1, 0); PG8_STAGE_A(PG8_SA(0, 1), a2, oC, 1);
            PG8_WAIT_V(8); PG8_WAIT_L(0); PG8_BAR; PG8_MMA(0, 0, At, B0); PG8_MMA(0, 1, At, B1); PG8_BAR; PG8_SCHED;
            PG8_LDA(At, 1, 1); PG8_STAGE_B(PG8_SB(1, 0), b3, 0); PG8_STAGE_B(PG8_SB(1, 1), b3, 1); PG8_STAGE_A(PG8_SA(1, 0), a3, oC, 0);
            PG8_WAIT_V(8); PG8_WAIT_L(0); PG8_BAR; PG8_MMA(1, 0, At, B0); PG8_MMA(1, 1, At, B1); PG8_BAR; PG8_SCHED;
            if constexpr (Epi::HAS_MID) { if (t + 2 == Epi::MIDT) { int fr2 = fr; asm volatile("" : "+v"(fr2)); E.mid(acc, cur, wr, fr2); } }
        }
        if (wr == 0) PG8_BAR;
        { int fr2 = fr, fq2 = fq; asm volatile("" : "+v"(fr2), "+v"(fq2)); E(acc, cur, wr, wc, fr2, fq2); }
        if (!has_next) break;
#pragma unroll
        for (int a = 0; a < 2; ++a)
#pragma unroll
            for (int b = 0; b < 2; ++b)
#pragma unroll
                for (int m = 0; m < 4; ++m)
#pragma unroll
                    for (int n = 0; n < 2; ++n) acc[a][b][m][n] = (f32x4){0.f, 0.f, 0.f, 0.f};
        cur = nxt; cA = nA; cB = nB; ++ui;
        if (wr == 1) PG8_BAR;
    }
    PG8_WAIT_V(0);
    PG8_BAR;
#undef PG8_SA
#undef PG8_SB
#undef PG8_STAGE_A
#undef PG8_STAGE_B
#undef PG8_LDA
#undef PG8_LDB
#undef PG8_MMA
#undef PG8_WAIT_V
#undef PG8_WAIT_L
#undef PG8_BAR
#undef PG8_SCHED
}

struct SrcPlain {
    static constexpr bool GATHER = false;
    const char* A; const char* B; unsigned lda, ldb;
    size_t abatch, bbatch, abatch2, bbatch2; int nInner;
    int nM, nN, nBatch, G, c; int nt, bks;
    __device__ __forceinline__ bool next(int i, Unit& u) const { const int L = i * G + c; if (L >= nM * nN * nBatch) return false; u.c = L / (nM * nN); const int r = L % (nM * nN); u.a = r / nN; u.b = r % nN; u.d = 0; return true; }
    __device__ __forceinline__ const char* abase(const Unit& u) const { return A + (size_t)(u.c / nInner) * abatch + (size_t)(u.c % nInner) * abatch2 + (size_t)u.a * 256 * lda; }
    __device__ __forceinline__ const char* bbase(const Unit& u) const { return B + (size_t)(u.c / nInner) * bbatch + (size_t)(u.c % nInner) * bbatch2 + (size_t)u.b * 256 * ldb; }
    __device__ __forceinline__ Off4 aoff(const Unit&, const int (&R)[2], const int (&C)[2]) const {
        Off4 o; o.h0i0 = (unsigned)R[0] * lda + (unsigned)C[0] * 2u; o.h0i1 = (unsigned)R[1] * lda + (unsigned)C[1] * 2u; o.h1i0 = o.h0i0 + 128u * lda; o.h1i1 = o.h0i1 + 128u * lda; return o; }
    __device__ __forceinline__ Off4 boff(const int (&Rb)[2][2], const int (&C)[2]) const {
        Off4 o; o.h0i0 = (unsigned)Rb[0][0] * ldb + (unsigned)C[0] * 2u; o.h0i1 = (unsigned)Rb[0][1] * ldb + (unsigned)C[1] * 2u; o.h1i0 = (unsigned)Rb[1][0] * ldb + (unsigned)C[0] * 2u; o.h1i1 = (unsigned)Rb[1][1] * ldb + (unsigned)C[1] * 2u; return o; }
};
}

#define E8_ROWS _Pragma("unroll") for (int ai = 0; ai < 2; ++ai) _Pragma("unroll") for (int m = 0; m < 4; ++m)
__device__ __forceinline__ u32x4 pk8(f32x4 a, f32x4 b) { u32x4 w; w.x = pk2(a[0], a[1]); w.y = pk2(a[2], a[3]); w.z = pk2(b[0], b[1]); w.w = pk2(b[2], b[3]); return w; }

struct EInproj8 {
    static constexpr int PERM = 1; static constexpr bool HAS_MID = false, HAS_PRE = false; static constexpr int MIDT = 0;
    bf16_t* U2; bf16_t* Q; bf16_t* K; bf16_t* V; const float* rope;
    __device__ __forceinline__ void operator()(pg8::Acc& acc, const pg8::Unit& u, int wr, int wc, int fr, int fq) {
        E8_ROWS { const int tok = u.a * 256 + ai * 128 + wr * 64 + m * 16 + fr;
#pragma unroll
            for (int bj = 0; bj < 2; ++bj) { const int col = u.b * 256 + bj * 128 + wc * 32 + 8 * fq; const f32x4 v0 = acc[ai][bj][m][0], v1 = acc[ai][bj][m][1];
                if (u.b < 2) { *(u32x4*)(U2 + ((size_t)(col >> 4) * NTOK + tok) * 16 + (col & 15)) = pk8(v0, v1); }
                else if (u.b >= 6) { *(u32x4*)(V + (size_t)tok * 512 + (col - 1536)) = pk8(v0, v1); }
                else { const int which = u.b >= 4, cc = col - (which ? 1024 : 512), j = (cc & 63) >> 1;
                    const f32x4 c0 = *(const f32x4*)(rope + ((size_t)tok * 32 + j) * 2), c1 = *(const f32x4*)(rope + ((size_t)tok * 32 + j) * 2 + 4);
                    f32x4 o0, o1; o0[0] = v0[0] * c0[0] - v0[1] * c0[1]; o0[1] = v0[1] * c0[0] + v0[0] * c0[1]; o0[2] = v0[2] * c0[2] - v0[3] * c0[3]; o0[3] = v0[3] * c0[2] + v0[2] * c0[3];
                    o1[0] = v1[0] * c1[0] - v1[1] * c1[1]; o1[1] = v1[1] * c1[0] + v1[0] * c1[1]; o1[2] = v1[2] * c1[2] - v1[3] * c1[3]; o1[3] = v1[3] * c1[2] + v1[2] * c1[3];
                    if (!which) { o0 = o0 * C2Q; o1 = o1 * C2Q; }
                    *(u32x4*)((which ? K : Q) + (size_t)tok * 512 + cc) = pk8(o0, o1); } } }
    }
};
struct EPlain8 {
    static constexpr int PERM = 1; static constexpr bool HAS_MID = false, HAS_PRE = false; static constexpr int MIDT = 0;
    bf16_t* out; size_t ldc; size_t obatch, obatch2; int nInner; const float* ssq; float cscale;
    __device__ __forceinline__ void operator()(pg8::Acc& acc, const pg8::Unit& u, int wr, int wc, int fr, int fq) {
        bf16_t* o = out + (size_t)(u.c / nInner) * obatch + (size_t)(u.c % nInner) * obatch2 + (size_t)u.a * 256 * ldc + u.b * 256;
        E8_ROWS { const int r = ai * 128 + wr * 64 + m * 16 + fr; float rs = cscale; if (ssq) rs *= rsqrtf(ssq[u.a * 256 + r] * (1.0f / 1024.0f) + EPS);
#pragma unroll
            for (int bj = 0; bj < 2; ++bj) *(u32x4*)(o + (size_t)r * ldc + bj * 128 + wc * 32 + 8 * fq) = pk8(acc[ai][bj][m][0] * rs, acc[ai][bj][m][1] * rs); }
    }
};
__device__ __forceinline__ float sigm(float x) { return 1.0f / (1.0f + __expf(-x)); }
struct EGlu8 {
    static constexpr int PERM = 1; static constexpr bool HAS_MID = false, HAS_PRE = false; static constexpr int MIDT = 0;
    const bf16_t* YG; bf16_t* YCAT; float* ssq;
    __device__ __forceinline__ void operator()(pg8::Acc& acc, const pg8::Unit& u, int wr, int wc, int fr, int fq) {
        E8_ROWS { const int tok = u.a * 256 + ai * 128 + wr * 64 + m * 16 + fr; float s = 0.f;
#pragma unroll
            for (int bj = 0; bj < 2; ++bj) { const int col = u.b * 256 + bj * 128 + wc * 32 + 8 * fq; const u32x4 yw = *(const u32x4*)(YG + (size_t)tok * 512 + col);
                const f32x4 a0 = acc[ai][bj][m][0], a1 = acc[ai][bj][m][1]; f32x4 o0, o1;
                o0[0] = bflo(yw.x) * sigm(a0[0]); o0[1] = bfhi(yw.x) * sigm(a0[1]); o0[2] = bflo(yw.y) * sigm(a0[2]); o0[3] = bfhi(yw.y) * sigm(a0[3]);
                o1[0] = bflo(yw.z) * sigm(a1[0]); o1[1] = bfhi(yw.z) * sigm(a1[1]); o1[2] = bflo(yw.w) * sigm(a1[2]); o1[3] = bfhi(yw.w) * sigm(a1[3]);
                s += (o0[0] * o0[0] + o0[1] * o0[1]) + (o0[2] * o0[2] + o0[3] * o0[3]) + (o1[0] * o1[0] + o1[1] * o1[1]) + (o1[2] * o1[2] + o1[3] * o1[3]);
                *(u32x4*)(YCAT + (size_t)tok * 1024 + col) = pk8(o0, o1); }
            ssq_add(s, ssq + tok, fq); }
    }
};
struct EOut8 {
    static constexpr int PERM = 1; static constexpr bool HAS_MID = true, HAS_PRE = false; static constexpr int MIDT = 8;
    const float* X; bf16_t* HB; const float* ssq_ssm; float* ssq1;
    __device__ __forceinline__ void mid(pg8::Acc& acc, const pg8::Unit& u, int wr, int fr) {
        E8_ROWS { const int tok = u.a * 256 + ai * 128 + wr * 64 + m * 16 + fr; const float rs = rsqrtf(ssq_ssm[tok] * (1.0f / 512.0f) + EPS);
#pragma unroll
            for (int bj = 0; bj < 2; ++bj) { acc[ai][bj][m][0] = acc[ai][bj][m][0] * rs; acc[ai][bj][m][1] = acc[ai][bj][m][1] * rs; } }
    }
    __device__ __forceinline__ void operator()(pg8::Acc& acc, const pg8::Unit& u, int wr, int wc, int fr, int fq) {
        E8_ROWS { const int tok = u.a * 256 + ai * 128 + wr * 64 + m * 16 + fr; float s = 0.f;
#pragma unroll
            for (int bj = 0; bj < 2; ++bj) { const size_t o = (size_t)tok * 1024 + u.b * 256 + bj * 128 + wc * 32 + 8 * fq;
                const f32x4 h0 = __builtin_nontemporal_load((const f32x4*)(X + o)) + acc[ai][bj][m][0], h1 = __builtin_nontemporal_load((const f32x4*)(X + o + 4)) + acc[ai][bj][m][1];
                s += (h0[0] * h0[0] + h0[1] * h0[1]) + (h0[2] * h0[2] + h0[3] * h0[3]) + (h1[0] * h1[0] + h1[1] * h1[1]) + (h1[2] * h1[2] + h1[3] * h1[3]);
                *(u32x4*)(HB + o) = pk8(h0, h1); }
            ssq_add(s, ssq1 + tok, fq); }
    }
};
struct EWo8 {
    static constexpr int PERM = 1; static constexpr bool HAS_MID = false, HAS_PRE = false; static constexpr int MIDT = 0;
    const bf16_t* HBin; bf16_t* HBout; float* ssq2;
    __device__ __forceinline__ void operator()(pg8::Acc& acc, const pg8::Unit& u, int wr, int wc, int fr, int fq) {
        E8_ROWS { const int tok = u.a * 256 + ai * 128 + wr * 64 + m * 16 + fr; float s = 0.f;
#pragma unroll
            for (int bj = 0; bj < 2; ++bj) { const size_t o = (size_t)tok * 1024 + u.b * 256 + bj * 128 + wc * 32 + 8 * fq; const u32x4 w = *(const u32x4*)(HBin + o);
                f32x4 h0 = acc[ai][bj][m][0], h1 = acc[ai][bj][m][1];
                h0[0] += bflo(w.x); h0[1] += bfhi(w.x); h0[2] += bflo(w.y); h0[3] += bfhi(w.y); h1[0] += bflo(w.z); h1[1] += bfhi(w.z); h1[2] += bflo(w.w); h1[3] += bfhi(w.w);
                s += (h0[0] * h0[0] + h0[1] * h0[1]) + (h0[2] * h0[2] + h0[3] * h0[3]) + (h1[0] * h1[0] + h1[1] * h1[1]) + (h1[2] * h1[2] + h1[3] * h1[3]);
                *(u32x4*)(HBout + o) = pk8(h0, h1); }
            ssq_add(s, ssq2 + tok, fq); }
    }
};
struct ESoftmax8 {
    static constexpr int PERM = 1; static constexpr bool HAS_MID = false, HAS_PRE = false; static constexpr int MIDT = 0;
    bf16_t* P; LAS float* red;
    __device__ __forceinline__ void operator()(pg8::Acc& acc, const pg8::Unit& u, int wr, int wc, int fr, int fq) {
        E8_ROWS { float v = -INFINITY;
#pragma unroll
            for (int bj = 0; bj < 2; ++bj)
#pragma unroll
                for (int n = 0; n < 2; ++n) v = fmaxf(fmaxf(v, fmaxf(acc[ai][bj][m][n][0], acc[ai][bj][m][n][1])), fmaxf(acc[ai][bj][m][n][2], acc[ai][bj][m][n][3]));
            v = fmaxf(v, SHX(v, 16)); v = sh32_max(v);
            if (fq == 0) red[(ai * 128 + wr * 64 + m * 16 + fr) * 4 + wc] = v; }
        LDS_WAIT(); __builtin_amdgcn_s_barrier(); asm volatile("" ::: "memory");
        E8_ROWS { const int r = ai * 128 + wr * 64 + m * 16 + fr; const f32x4 q = *(const LAS f32x4*)(red + r * 4); const float mm = fmaxf(fmaxf(q[0], q[1]), fmaxf(q[2], q[3])); float s = 0.f;
#pragma unroll
            for (int bj = 0; bj < 2; ++bj)
#pragma unroll
                for (int n = 0; n < 2; ++n) { f32x4 p; p[0] = __builtin_amdgcn_exp2f(acc[ai][bj][m][n][0] - mm); p[1] = __builtin_amdgcn_exp2f(acc[ai][bj][m][n][1] - mm); p[2] = __builtin_amdgcn_exp2f(acc[ai][bj][m][n][2] - mm); p[3] = __builtin_amdgcn_exp2f(acc[ai][bj][m][n][3] - mm);
                    acc[ai][bj][m][n] = p; s += (p[0] + p[1]) + (p[2] + p[3]); }
            s += SHX(s, 16); s = sh32_sum(s);
            if (fq == 0) red[1024 + r * 4 + wc] = s; }
        LDS_WAIT(); __builtin_amdgcn_s_barrier(); asm volatile("" ::: "memory");
        const int b = u.c >> 2, h = u.c & 3;
        bf16_t* o = P + ((size_t)b * SEQ + u.a * 256) * 1024 + h * 256;
        E8_ROWS { const int r = ai * 128 + wr * 64 + m * 16 + fr; const f32x4 q = *(const LAS f32x4*)(red + 1024 + r * 4); const float inv = 1.0f / ((q[0] + q[1]) + (q[2] + q[3]));
#pragma unroll
            for (int bj = 0; bj < 2; ++bj) *(u32x4*)(o + (size_t)r * 1024 + bj * 128 + wc * 32 + 8 * fq) = pk8(acc[ai][bj][m][0] * inv, acc[ai][bj][m][1] * inv); }
        LDS_WAIT(); __builtin_amdgcn_s_barrier(); asm volatile("" ::: "memory");
    }
};
struct EGateUp8 {
    static constexpr int PERM = 1; static constexpr bool HAS_MID = false, HAS_PRE = true; static constexpr int MIDT = 0;
    const float* slotw; const float* slotrs;
    const float* ssq2; bf16_t* HID;
    typedef _Float16 h2_t __attribute__((ext_vector_type(2)));
    h2_t wrs_[8];
    __device__ __forceinline__ void pre(const pg8::Unit& u, int wr, int fr) {
#pragma unroll
        for (int ai = 0; ai < 2; ++ai)
#pragma unroll
            for (int m = 0; m < 4; ++m) { const int r = ai * 128 + wr * 64 + m * 16 + fr; float w, rs;
                if (slotw) { w = slotw[u.a * 256 + r]; rs = slotrs[u.a * 256 + r]; }
                else { w = 1.0f; rs = rsqrtf(ssq2[u.a * 256 + r] * (1.0f / 1024.0f) + EPS); }
                wrs_[ai * 4 + m] = (h2_t){(_Float16)w, (_Float16)rs}; }
    }
    __device__ __forceinline__ void operator()(pg8::Acc& acc, const pg8::Unit& u, int wr, int wc, int fr, int fq) {
        E8_ROWS { const int r = ai * 128 + wr * 64 + m * 16 + fr; const float w = (float)wrs_[ai * 4 + m].x, rs = (float)wrs_[ai * 4 + m].y;
            f32x4 o[2];
#pragma unroll
            for (int n = 0; n < 2; ++n) { const f32x4 gg = acc[ai][0][m][n] * rs, uu = acc[ai][1][m][n] * rs;
#pragma unroll
                for (int i = 0; i < 4; ++i) o[n][i] = w * (gg[i] * sigm(gg[i])) * uu[i]; }
            *(u32x4*)(HID + (size_t)(slotw ? (u.d + r) : (u.a * 256 + r)) * 256 + u.b * 128 + wc * 32 + 8 * fq) = pk8(o[0], o[1]); }
    }
};
struct EDownY8 {
    static constexpr int PERM = 2; static constexpr bool HAS_MID = false, HAS_PRE = true; static constexpr int MIDT = 0;
    const int* slot; int aid0; bf16_t* Y; int a_[8];
    __device__ __forceinline__ void pre(const pg8::Unit& u, int wr, int fr) {
#pragma unroll
        for (int ai = 0; ai < 2; ++ai)
#pragma unroll
            for (int m = 0; m < 4; ++m) a_[ai * 4 + m] = slot[u.a * 256 + ai * 128 + wr * 64 + m * 16 + fr];
    }
    __device__ __forceinline__ void operator()(pg8::Acc& acc, const pg8::Unit& u, int wr, int wc, int fr, int fq) {
        E8_ROWS { const int a = a_[ai * 4 + m];
            if (a >= 0) { unsigned char* p = (unsigned char*)Y + (size_t)(a - aid0) * 1024 + u.b * 256 + wc * 64 + 16 * fq;
                u32x4 w;
                { const f32x4 c0 = acc[ai][0][m][0] * YSC, c1 = acc[ai][0][m][1] * YSC, c2 = acc[ai][1][m][0] * YSC, c3 = acc[ai][1][m][1] * YSC;
                  w.x = __builtin_amdgcn_cvt_pk_fp8_f32(c0[2], c0[3], __builtin_amdgcn_cvt_pk_fp8_f32(c0[0], c0[1], 0, false), true);
                  w.y = __builtin_amdgcn_cvt_pk_fp8_f32(c1[2], c1[3], __builtin_amdgcn_cvt_pk_fp8_f32(c1[0], c1[1], 0, false), true);
                  w.z = __builtin_amdgcn_cvt_pk_fp8_f32(c2[2], c2[3], __builtin_amdgcn_cvt_pk_fp8_f32(c2[0], c2[1], 0, false), true);
                  w.w = __builtin_amdgcn_cvt_pk_fp8_f32(c3[2], c3[3], __builtin_amdgcn_cvt_pk_fp8_f32(c3[0], c3[1], 0, false), true); }
                __builtin_nontemporal_store(w, (u32x4*)p); } }
    }
};
struct EShared8 {
    static constexpr int PERM = 2; static constexpr bool HAS_MID = false, HAS_PRE = false; static constexpr int MIDT = 0;
    unsigned char* ys;
    __device__ __forceinline__ void operator()(pg8::Acc& acc, const pg8::Unit& u, int wr, int wc, int fr, int fq) {
        unsigned char* o = ys + (size_t)u.a * 256 * 1024 + u.b * 256 + wc * 64 + 16 * fq;
        E8_ROWS { const int r = ai * 128 + wr * 64 + m * 16 + fr; u32x4 w;
            const f32x4 c0 = acc[ai][0][m][0] * YSC, c1 = acc[ai][0][m][1] * YSC, c2 = acc[ai][1][m][0] * YSC, c3 = acc[ai][1][m][1] * YSC;
            w.x = __builtin_amdgcn_cvt_pk_fp8_f32(c0[2], c0[3], __builtin_amdgcn_cvt_pk_fp8_f32(c0[0], c0[1], 0, false), true);
            w.y = __builtin_amdgcn_cvt_pk_fp8_f32(c1[2], c1[3], __builtin_amdgcn_cvt_pk_fp8_f32(c1[0], c1[1], 0, false), true);
            w.z = __builtin_amdgcn_cvt_pk_fp8_f32(c2[2], c2[3], __builtin_amdgcn_cvt_pk_fp8_f32(c2[0], c2[1], 0, false), true);
            w.w = __builtin_amdgcn_cvt_pk_fp8_f32(c3[2], c3[3], __builtin_amdgcn_cvt_pk_fp8_f32(c3[0], c3[1], 0, false), true);
            __builtin_nontemporal_store(w, (u32x4*)(o + (size_t)r * 1024)); }
    }
};
template <bool GATH> struct SrcMoe {
    static constexpr bool GATHER = GATH;
    const char* A; unsigned lda; const int* slot; int qbase;
    const char* B; unsigned ldb; size_t bexp; int nct;
    const LAS int* texp; int t0, nu, G, c; int nt, bks;
    __device__ __forceinline__ bool next(int i, pg8::Unit& u) const { const int L = i * G + c; if (L >= nu) return false; const int t = t0 + L / nct; u.a = t; u.b = L % nct;
        u.c = __builtin_amdgcn_readfirstlane(texp[t - t0]); u.d = t * 256 - qbase; return true; }
    __device__ __forceinline__ const char* abase(const pg8::Unit& u) const { return GATH ? A : A + (size_t)u.d * lda; }
    __device__ __forceinline__ const char* bbase(const pg8::Unit& u) const { return B + (size_t)u.c * bexp + (size_t)u.b * 256 * ldb; }
    __device__ __forceinline__ unsigned rowoff(const pg8::Unit& u, int row) const { if (GATH) { const int a = slot[u.a * 256 + row]; row = a < 0 ? 0 : (a >> 3); } return (unsigned)row * lda; }
    __device__ __forceinline__ pg8::Off4 aoff(const pg8::Unit& u, const int (&R)[2], const int (&C)[2]) const {
        pg8::Off4 o; o.h0i0 = rowoff(u, R[0]) + (unsigned)C[0] * 2u; o.h0i1 = rowoff(u, R[1]) + (unsigned)C[1] * 2u; o.h1i0 = rowoff(u, 128 + R[0]) + (unsigned)C[0] * 2u; o.h1i1 = rowoff(u, 128 + R[1]) + (unsigned)C[1] * 2u; return o; }
    __device__ __forceinline__ pg8::Off4 boff(const int (&Rb)[2][2], const int (&C)[2]) const {
        pg8::Off4 o; o.h0i0 = (unsigned)Rb[0][0] * ldb + (unsigned)C[0] * 2u; o.h0i1 = (unsigned)Rb[0][1] * ldb + (unsigned)C[1] * 2u; o.h1i0 = (unsigned)Rb[1][0] * ldb + (unsigned)C[0] * 2u; o.h1i1 = (unsigned)Rb[1][1] * ldb + (unsigned)C[1] * 2u; return o; }
};

struct SrcToep {
    static constexpr bool GATHER = false;
    const char* U2p; const char* KDX; int G, c; int nt, bks;
    __device__ __forceinline__ bool next(int i, pg8::Unit& u) const { const int L = i * G + c; if (L >= 256) return false; u.c = L >> 3; u.a = (L >> 2) & 1; u.b = L & 3; u.d = 0; return true; }
    __device__ __forceinline__ const char* abase(const pg8::Unit& u) const { return U2p + ((size_t)u.c * NTOK * 16 + (size_t)u.a * 256 * 1024) * 2; }
    __device__ __forceinline__ const char* bbase(const pg8::Unit& u) const { return KDX + ((size_t)u.c * KDG + (size_t)u.b * 16 * 256) * 2; }
    __device__ __forceinline__ pg8::Off4 aoff(const pg8::Unit&, const int (&R)[2], const int (&C)[2]) const {
        pg8::Off4 o; o.h0i0 = (unsigned)R[0] * 2048u + (unsigned)C[0] * 2u; o.h0i1 = (unsigned)R[1] * 2048u + (unsigned)C[1] * 2u; o.h1i0 = o.h0i0 + 128u * 2048u; o.h1i1 = o.h0i1 + 128u * 2048u; return o; }
    __device__ __forceinline__ unsigned bo(int n, int C) const { return (unsigned)((((n >> 4) + 63 - (C >> 4)) * 256 + (n & 15) * 16 + (C & 15)) * 2); }
    __device__ __forceinline__ pg8::Off4 boff(const int (&Rb)[2][2], const int (&C)[2]) const { pg8::Off4 o; o.h0i0 = bo(Rb[0][0], C[0]); o.h0i1 = bo(Rb[0][1], C[1]); o.h1i0 = bo(Rb[1][0], C[0]); o.h1i1 = bo(Rb[1][1], C[1]); return o; }
};
struct ESsmT8 {
    static constexpr int PERM = 1; static constexpr bool HAS_MID = false, HAS_PRE = false; static constexpr int MIDT = 0;
    float* Y;
    __device__ __forceinline__ void operator()(pg8::Acc& acc, const pg8::Unit& u, int wr, int wc, int fr, int fq) {
        E8_ROWS { const int rr = u.a * 256 + ai * 128 + wr * 64 + m * 16 + fr; const size_t tokb = (size_t)(rr >> 6) * SEQ + (rr & 63) * 64;
#pragma unroll
            for (int bj = 0; bj < 2; ++bj) { const int nn = u.b * 256 + bj * 128 + wc * 32 + 8 * fq; float* p = Y + (tokb + (nn >> 4)) * 512 + u.c * 16 + (nn & 15);
                *(f32x4*)p = acc[ai][bj][m][0]; *(f32x4*)(p + 4) = acc[ai][bj][m][1]; } }
    }
};
struct ESsmS8 {
    static constexpr int PERM = 0; static constexpr bool HAS_MID = false, HAS_PRE = false; static constexpr int MIDT = 0;
    float* S;
    __device__ __forceinline__ void operator()(pg8::Acc& acc, const pg8::Unit& u, int wr, int wc, int fr, int fq) {
        E8_ROWS { const int rr = u.a * 256 + ai * 128 + wr * 64 + m * 16 + fr; float* p = S + ((size_t)u.c * 512 + rr) * 128 + wc * 32 + 4 * fq;
            *(f32x4*)p = acc[ai][0][m][0]; *(f32x4*)(p + 16) = acc[ai][0][m][1]; }
    }
};
struct Args { const void* in[37]; float* out; unsigned char* ws; int ph_lo, ph_hi; };
constexpr int NPHASE = 21;

__device__ __forceinline__ void ssm_pow(float lr, float li, float dt, float n, float& re, float& im) {
    const float mag = expf(n * lr * dt); float s, c; sincosf(n * (li * dt), &s, &c); re = mag * c; im = mag * s;
}
__device__ __forceinline__ void ssm_k(float lr, float li, float dt, float& kre, float& kim) {
    float ar, ai; ssm_pow(lr, li, dt, 1.0f, ar, ai); const float zr = ar - 1.0f, zi = ai, den = lr * lr + li * li;
    kre = (zr * lr + zi * li) / den; kim = (zi * lr - zr * li) / den;
}

__device__ __forceinline__ int rowmap(int kind, int n) {
    if (kind == 1) { if (n >= 512 && n < 1536) { const int j = n & 63; return (n & ~63) + (j < 32 ? 2 * j : 2 * (j - 32) + 1); } return n; }
    if (kind == 2) return (n >> 7) * 256 + (n & 127);
    if (kind == 3) return (n >> 7) * 256 + 128 + (n & 127);
    return n;
}
struct TrDesc { const float* src; bf16_t* dst; const float* kscale; int K, N, kind, klim, item; };
__device__ __forceinline__ void tr_load(const TrDesc& d, f32x4 (&v)[16], int lane) {
    const int nblk = d.N / 64, k0 = 64 * (d.item / nblk), n0 = 64 * (d.item % nblk), kr = lane >> 4, nc = (lane & 15) * 4;
#pragma unroll
    for (int r = 0; r < 16; ++r) v[r] = __builtin_nontemporal_load((const f32x4*)(d.src + (size_t)(k0 + r * 4 + kr) * d.N + n0 + nc));
}
__device__ __forceinline__ void tr_store(const TrDesc& d, const f32x4 (&v)[16], LAS unsigned char* scr, int lane) {
    const int nblk = d.N / 64, k0 = 64 * (d.item / nblk), n0 = 64 * (d.item % nblk), kr = lane >> 4, nc = (lane & 15) * 4;
#pragma unroll
    for (int r = 0; r < 16; ++r) { const int k = r * 4 + kr; f32x4 t = v[r]; if (d.kscale && (k0 + k) < d.klim) t = t * d.kscale[k0 + k];
        const unsigned w0 = pk2(t[0], t[1]), w1 = pk2(t[2], t[3]);
        *(LAS bf16_t*)(scr + (nc + 0) * 144 + k * 2) = (bf16_t)(w0 & 0xffffu); *(LAS bf16_t*)(scr + (nc + 1) * 144 + k * 2) = (bf16_t)(w0 >> 16);
        *(LAS bf16_t*)(scr + (nc + 2) * 144 + k * 2) = (bf16_t)(w1 & 0xffffu); *(LAS bf16_t*)(scr + (nc + 3) * 144 + k * 2) = (bf16_t)(w1 >> 16); }
    LDS_WAIT();
#pragma unroll
    for (int j = 0; j < 8; ++j) { const int id = lane + 64 * j, row = id >> 3, ch = id & 7;
        const u32x4 o = *(const LAS u32x4*)(scr + row * 144 + ch * 16);
        __builtin_nontemporal_store(o, (u32x4*)(d.dst + (size_t)rowmap(d.kind, n0 + row) * d.K + k0 + ch * 8)); }
    LDS_WAIT();
}
__device__ __forceinline__ void rms_row2_bf16(const float* xa, const float* xb, const float* g, bf16_t* oa, bf16_t* ob, int lane) {
    f32x4 va[4], vb[4]; float sa = 0.f, sb = 0.f;
#pragma unroll
    for (int j = 0; j < 4; ++j) { va[j] = __builtin_nontemporal_load((const f32x4*)(xa + (lane + 64 * j) * 4)); vb[j] = __builtin_nontemporal_load((const f32x4*)(xb + (lane + 64 * j) * 4)); }
#pragma unroll
    for (int j = 0; j < 4; ++j) { sa += (va[j][0] * va[j][0] + va[j][1] * va[j][1]) + (va[j][2] * va[j][2] + va[j][3] * va[j][3]); sb += (vb[j][0] * vb[j][0] + vb[j][1] * vb[j][1]) + (vb[j][2] * vb[j][2] + vb[j][3] * vb[j][3]); }
    const float ra = rsqrtf(wave_sum(sa) * (1.0f / 1024.0f) + EPS), rb = rsqrtf(wave_sum(sb) * (1.0f / 1024.0f) + EPS);
#pragma unroll
    for (int j = 0; j < 4; ++j) { const f32x4 gg = *(const f32x4*)(g + (lane + 64 * j) * 4); const f32x4 ta = va[j] * ra * gg, tb = vb[j] * rb * gg;
        __builtin_nontemporal_store((u32x2){pk2(ta[0], ta[1]), pk2(ta[2], ta[3])}, (u32x2*)(oa + (lane + 64 * j) * 4)); __builtin_nontemporal_store((u32x2){pk2(tb[0], tb[1]), pk2(tb[2], tb[3])}, (u32x2*)(ob + (lane + 64 * j) * 4)); }
}
__device__ __forceinline__ void rms_row_bf16(const float* xr, const float* g, bf16_t* orow, int lane) {
    f32x4 v[4]; float s = 0.f;
#pragma unroll
    for (int j = 0; j < 4; ++j) { v[j] = *(const f32x4*)(xr + (lane + 64 * j) * 4); s += (v[j][0] * v[j][0] + v[j][1] * v[j][1]) + (v[j][2] * v[j][2] + v[j][3] * v[j][3]); }
    const float rs = rsqrtf(wave_sum(s) * (1.0f / 1024.0f) + EPS);
#pragma unroll
    for (int j = 0; j < 4; ++j) { const f32x4 gg = *(const f32x4*)(g + (lane + 64 * j) * 4); st4bf(orow + (lane + 64 * j) * 4, v[j] * rs * gg); }
}


constexpr int CV_ITEMS = 3 * 64 * 64, CVW = 4;
__device__ __forceinline__ void cv_moe_item(int it, int lane, LAS unsigned char* scr, const float* wg, const float* wu, const float* wdn, const float* gffn, unsigned char* ws) {
    TrDesc d;
    if (it < 4096) d = TrDesc{wg + (size_t)(it >> 6) * 262144, (bf16_t*)(ws + WS_WGU) + (size_t)(it >> 6) * 524288, gffn, 1024, 256, 2, 1024, it & 63};
    else if (it < 8192) d = TrDesc{wu + (size_t)((it - 4096) >> 6) * 262144, (bf16_t*)(ws + WS_WGU) + (size_t)((it - 4096) >> 6) * 524288, gffn, 1024, 256, 3, 1024, it & 63};
    else d = TrDesc{wdn + (size_t)((it - 8192) >> 6) * 262144, (bf16_t*)(ws + WS_WD) + (size_t)((it - 8192) >> 6) * 262144, nullptr, 256, 1024, 0, 0, it & 63};
    f32x4 v[16]; tr_load(d, v, lane); tr_store(d, v, scr, lane);
}
__device__ __forceinline__ void xcd_barrier_cv(const XcdBarrier& b, LAS unsigned char* lds, int ord, int vcu, int G, const float* wg, const float* wu, const float* wdn, const float* gffn, unsigned char* ws) {

    asm volatile("s_waitcnt vmcnt(0)" ::: "memory");
    __syncthreads();
    if (threadIdx.x == 0) {
        unsigned* bar = b.bar;
        __builtin_amdgcn_s_waitcnt(0);
        unsigned nloc = b.st[0], nx = b.st[1];
        if (nloc == 0u) { xcd_barrier_complete(bar, b.x, nloc, nx); b.st[0] = nloc; b.st[1] = nx; }
        const unsigned old = xb_add(&bar[XB_XSUB(b.x)], 1u);
        const unsigned gen = old / nloc;
        if (old + 1u == (gen + 1u) * nloc) {
            __builtin_amdgcn_fence(__ATOMIC_RELEASE, "agent");
            asm volatile("s_waitcnt vmcnt(0)" ::: "memory");
            const unsigned og = xb_add(&bar[XB_TOP], 1u);
            const unsigned tg = og / nx;
            if (og + 1u == (tg + 1u) * nx) xb_add(&bar[XB_TOPGEN], 1u);
            else XB_SPIN(xb_ld(&bar[XB_TOPGEN]) == tg, bar);
            __builtin_amdgcn_fence(__ATOMIC_ACQUIRE, "agent");
            xb_add(&bar[XB_XGEN(b.x)], 1u);
            asm volatile("s_waitcnt vmcnt(0)" ::: "memory");
        } else {
            XB_SPIN(xb_ld(&bar[XB_XGEN(b.x)]) == gen, bar);
            __builtin_amdgcn_fence(__ATOMIC_ACQUIRE, "agent");
            asm volatile("s_waitcnt vmcnt(0)" ::: "memory");
        }
    } else {
        int tid = threadIdx.x; asm volatile("" : "+v"(tid));
        const int wave = __builtin_amdgcn_readfirstlane(tid >> 6);
        if (wave >= 1 && wave <= CVW) { const int it = (ord * G + vcu) * CVW + (wave - 1); if (it < CV_ITEMS) cv_moe_item(it, tid & 63, lds + wave * 9216, wg, wu, wdn, gffn, ws); }
    }
    __syncthreads();
}

__global__ void __launch_bounds__(512, 2) fwd_kernel(Args args) {
    extern __shared__ __attribute__((aligned(16))) unsigned char lds_raw[];
    LAS unsigned char* lds = (LAS unsigned char*)lds_raw;
    const int G = gridDim.x; const int bx = blockIdx.x;
#define PHASE_TID() int tid = threadIdx.x; asm volatile("" : "+v"(tid)); const int lane = tid & 63; const int wave = __builtin_amdgcn_readfirstlane(tid >> 6); \
    const int gw_ = vcu * 8 + wave, NGW = G * 8, gt_ = vcu * 512 + tid, NGT = G * 512; (void)lane; (void)gw_; (void)NGW; (void)gt_; (void)NGT;
    const int vcu = (G % 8 == 0) ? (bx % 8) * (G / 8) + bx / 8 : bx;
    unsigned char* ws = args.ws;
    unsigned* ctl = (unsigned*)(ws + WS_CTL);
    volatile LAS unsigned* MISC = (volatile LAS unsigned*)(lds + LDS_MISC);
    if (threadIdx.x < 64) MISC[threadIdx.x] = 0u;
    __syncthreads();
#if MK_ONE_LAUNCH
    XcdBarrier bar = xcd_barrier_post(ctl + CW_BAR, MISC + 8);
#define GRID_BAR() xcd_barrier(bar)
#define GRID_BAR_CV(o) xcd_barrier_cv(bar, lds, (o), vcu, G, (const float*)args.in[30], (const float*)args.in[31], (const float*)args.in[32], (const float*)args.in[27], ws)
#else
#define GRID_BAR() do {} while (0)
#define GRID_BAR_CV(o) do {} while (0)
#endif
    const int lo = args.ph_lo, hi_ = args.ph_hi;
#ifndef PHASE_MASK
#define PHASE_MASK 0xFFFFFFFFu
#endif
#define IN(k) (((PHASE_MASK >> (k)) & 1u) && lo <= (k) && (k) < hi_)
#define SEAM(k) do { if (IN(k) && IN((k) + 1)) { if ((k) <= 10 || (k) == 12) GRID_BAR_CV((k) == 12 ? 11 : (k)); else GRID_BAR(); } } while (0)
#ifndef REPEAT_MASK
#define REPEAT_MASK 0u
#endif
#define REPK(k) ((int)((REPEAT_MASK >> (k)) & 1u))

#define x_in ((const float*)args.in[0])
#define mem_in ((const float*)args.in[1])
#define positions ((const int*)args.in[2])
#define g_mix ((const float*)args.in[3])
#define w_in ((const float*)args.in[4])
#define a_re ((const float*)args.in[5])
#define a_im ((const float*)args.in[6])
#define log_dt ((const float*)args.in[7])
#define b_re ((const float*)args.in[8])
#define b_im ((const float*)args.in[9])
#define c_re ((const float*)args.in[10])
#define c_im ((const float*)args.in[11])
#define d_skip ((const float*)args.in[12])
#define w_glu ((const float*)args.in[13])
#define g_ssm_out ((const float*)args.in[14])
#define lam_q1 ((const float*)args.in[15])
#define lam_k1 ((const float*)args.in[16])
#define lam_q2 ((const float*)args.in[17])
#define lam_k2 ((const float*)args.in[18])
#define g_sub ((const float*)args.in[19])
#define w_out ((const float*)args.in[20])
#define g_x ((const float*)args.in[21])
#define g_mem ((const float*)args.in[22])
#define wq_x ((const float*)args.in[23])
#define wk_x ((const float*)args.in[24])
#define wv_x ((const float*)args.in[25])
#define wo_x ((const float*)args.in[26])
#define g_ffn ((const float*)args.in[27])
#define w_router ((const float*)args.in[28])
#define router_bias ((const float*)args.in[29])
#define w_gate ((const float*)args.in[30])
#define w_up ((const float*)args.in[31])
#define w_down ((const float*)args.in[32])
#define ws_gate ((const float*)args.in[33])
#define ws_up ((const float*)args.in[34])
#define ws_down ((const float*)args.in[35])
#define g_final ((const float*)args.in[36])
#define H (args.out)
#define WIN ((bf16_t*)(ws + WS_WIN))
#define WV ((bf16_t*)(ws + WS_WV))
#define WGLU ((bf16_t*)(ws + WS_WGLU))
#define WR ((bf16_t*)(ws + WS_WR))
#define WSD ((bf16_t*)(ws + WS_WSD))
#define WOUT ((bf16_t*)(ws + WS_WOUT))
#define WQX ((bf16_t*)(ws + WS_WQX))
#define WKX ((bf16_t*)(ws + WS_WKX))
#define WVX ((bf16_t*)(ws + WS_WVX))
#define WOX ((bf16_t*)(ws + WS_WOX))
#define WSGU ((bf16_t*)(ws + WS_WSGU))
#define WGU ((bf16_t*)(ws + WS_WGU))
#define WD ((bf16_t*)(ws + WS_WD))
#define WST ((bf16_t*)(ws + WS_WST))
#define WYT ((bf16_t*)(ws + WS_WYT))
#define KD ((bf16_t*)(ws + WS_KD))
#define POWT ((float*)(ws + WS_POWT))
#define BBAR ((float*)(ws + WS_BBAR))
#define ROPE ((float*)(ws + WS_ROPE))
#define MEMN ((bf16_t*)(ws + WS_MEMN))
#define KX ((bf16_t*)(ws + WS_KX))
#define VXT ((bf16_t*)(ws + WS_VXT))
#define SST ((float*)(ws + WS_S))
#define EST ((bf16_t*)(ws + WS_E))
#define LOGIT ((float*)(ws + WS_LOGIT))
#define EIDX ((int*)(ws + WS_EIDX))
#define GW ((float*)(ws + WS_GW))
#define SLOT ((int*)(ws + WS_SLOT))
#define XN ((bf16_t*)(ws + WS_A0))
#define YINTRA ((float*)(ws + WS_A0))
#define HB ((bf16_t*)(ws + WS_A0))
#define U2 ((bf16_t*)(ws + WS_U2))
#define Qb ((bf16_t*)(ws + WS_Q))
#define Kb ((bf16_t*)(ws + WS_K))
#define VT ((bf16_t*)(ws + WS_VT))
#define YCAT ((bf16_t*)(ws + WS_YCAT))
#define QX ((bf16_t*)(ws + WS_QX))
#define PX ((bf16_t*)(ws + WS_PX))
#define YG ((bf16_t*)(ws + WS_YG))
#define OX ((bf16_t*)(ws + WS_OX))
#define HID ((bf16_t*)(ws + WS_HID))
#define HIDS ((bf16_t*)(ws + WS_HIDS))
#define SSQ0 ((float*)(ws + CB_SSQ0))
#define SSQ1 ((float*)(ws + CB_SSQ1))
#define SSQ2 ((float*)(ws + CB_SSQ2))
#define BLKHIST ((int*)(ws + CB_BLKHIST))
#define CNT ((int*)(ctl + CW_CNT))

    if (IN(0)) for (int rep_ = 0; rep_ <= REPK(0); ++rep_) {
        PHASE_TID();
        LAS unsigned char* scr = lds + wave * 9216;
        for (int gb = vcu; gb < 256; gb += G) { const int g = gb >> 3, sub = gb & 7;
            LAS f32x2_t* PW = (LAS f32x2_t*)(lds + 73728); LAS f32x2_t* BBl = (LAS f32x2_t*)(lds + 73728 + 65 * 64 * 8);
            const float dt = expf(log_dt[g]);
            for (int i = tid; i < 65 * 64; i += 512) { const int p = i & 63, d = i >> 6; float pr, pi; ssm_pow(a_re[g * 64 + p], a_im[g * 64 + p], dt, (float)d, pr, pi); PW[i] = (f32x2_t){pr, pi}; }
            for (int i = tid; i < 64 * 16; i += 512) { const int p = i >> 4; float kre, kim; ssm_k(a_re[g * 64 + p], a_im[g * 64 + p], dt, kre, kim); const float br = b_re[g * 1024 + i], bi = b_im[g * 1024 + i];
                BBl[i] = (f32x2_t){kre * br - kim * bi, kre * bi + kim * br}; }
            __syncthreads();
            if (tid < 508) { const int item = sub * 508 + tid, hq = item & 1, c = (item >> 1) & 15, dd = item >> 5, d = dd - 63;
                float acc[8];
#pragma unroll
                for (int q = 0; q < 8; ++q) acc[q] = 0.f;
                if (d >= 0) { const float* cr = c_re + (g * 16 + c) * 64; const float* ci = c_im + (g * 16 + c) * 64;
#pragma unroll 4
                    for (int p = 0; p < 64; ++p) { const f32x2_t a = PW[d * 64 + p]; const float wre = cr[p] * a.x - ci[p] * a.y, wim = cr[p] * a.y + ci[p] * a.x;
#pragma unroll
                        for (int q = 0; q < 8; ++q) { const f32x2_t bq = BBl[p * 16 + hq * 8 + q]; acc[q] += wre * bq.x - wim * bq.y; } } }
                u32x4 o0; o0.x = pk2(acc[0], acc[1]); o0.y = pk2(acc[2], acc[3]); o0.z = pk2(acc[4], acc[5]); o0.w = pk2(acc[6], acc[7]);
                *(u32x4*)(KD + ((size_t)g * 127 * 32 + item) * 8) = o0; }
            { const int item = sub * 512 + tid, p = item >> 6, s = item & 63;
                const f32x2_t a = PW[(63 - s) * 64 + p]; float re[16], im[16];
#pragma unroll
                for (int q = 0; q < 16; ++q) { const f32x2_t bq = BBl[p * 16 + q]; re[q] = a.x * bq.x - a.y * bq.y; im[q] = a.x * bq.y + a.y * bq.x; }
                bf16_t* d0 = WST + ((size_t)(g * 256 + p) * 1024 + s * 16); bf16_t* d1 = WST + ((size_t)(g * 256 + 64 + p) * 1024 + s * 16);
                { const u32x4 z = (u32x4){0u, 0u, 0u, 0u}; *(u32x4*)(d0 + 128 * 1024) = z; *(u32x4*)(d0 + 128 * 1024 + 8) = z; *(u32x4*)(d1 + 128 * 1024) = z; *(u32x4*)(d1 + 128 * 1024 + 8) = z; }
                u32x4 o; o.x = pk2(re[0], re[1]); o.y = pk2(re[2], re[3]); o.z = pk2(re[4], re[5]); o.w = pk2(re[6], re[7]); *(u32x4*)d0 = o;
                o.x = pk2(re[8], re[9]); o.y = pk2(re[10], re[11]); o.z = pk2(re[12], re[13]); o.w = pk2(re[14], re[15]); *(u32x4*)(d0 + 8) = o;
                o.x = pk2(im[0], im[1]); o.y = pk2(im[2], im[3]); o.z = pk2(im[4], im[5]); o.w = pk2(im[6], im[7]); *(u32x4*)d1 = o;
                o.x = pk2(im[8], im[9]); o.y = pk2(im[10], im[11]); o.z = pk2(im[12], im[13]); o.w = pk2(im[14], im[15]); *(u32x4*)(d1 + 8) = o; }
#pragma unroll 2
            for (int j = 0; j < 8; ++j) { const int item = sub * 4096 + j * 512 + tid, p2 = (item & 31) * 2, c = (item >> 5) & 15, tp = item >> 9;
                const f32x2_t a0 = PW[(tp + 1) * 64 + p2], a1 = PW[(tp + 1) * 64 + p2 + 1];
                const float cr0 = c_re[(g * 16 + c) * 64 + p2], ci0 = c_im[(g * 16 + c) * 64 + p2], cr1 = c_re[(g * 16 + c) * 64 + p2 + 1], ci1 = c_im[(g * 16 + c) * 64 + p2 + 1];
                bf16_t* d = WYT + ((size_t)(g * 1024 + tp * 16 + c) * 128 + p2);
                *(unsigned*)d = pk2(cr0 * a0.x - ci0 * a0.y, cr1 * a1.x - ci1 * a1.y); *(unsigned*)(d + 64) = pk2(-(cr0 * a0.y + ci0 * a0.x), -(cr1 * a1.y + ci1 * a1.x)); }
            __syncthreads();
        }
        constexpr int I_IN = 512, I_GLU = 64, I_SQ = 256, I_R = 16, I_SG = 64, I_E = 64;
        constexpr int NIT = I_IN + I_GLU + 5 * I_SQ + I_R + 3 * I_SG + (MK_ONE_LAUNCH ? 0 : 3 * 64 * I_E);
        auto decode = [&](int it) -> TrDesc {
            int r = it;
            if (r < I_IN) return TrDesc{w_in, WIN, nullptr, 1024, 2048, 1, 0, r}; r -= I_IN;
            if (r < I_GLU) return TrDesc{w_glu, WGLU, nullptr, 512, 512, 0, 0, r}; r -= I_GLU;
            if (r < I_SQ) return TrDesc{w_out, WOUT, g_ssm_out, 1024, 1024, 0, 512, r}; r -= I_SQ;
            if (r < I_SQ) return TrDesc{wq_x, WQX, g_x, 1024, 1024, 0, 1024, r}; r -= I_SQ;
            if (r < I_SQ) return TrDesc{wk_x, WKX, nullptr, 1024, 1024, 0, 0, r}; r -= I_SQ;
            if (r < I_SQ) return TrDesc{wv_x, WVX, nullptr, 1024, 1024, 0, 0, r}; r -= I_SQ;
            if (r < I_SQ) return TrDesc{wo_x, WOX, nullptr, 1024, 1024, 0, 0, r}; r -= I_SQ;
            if (r < I_R) return TrDesc{w_router, WR, g_ffn, 1024, 64, 0, 1024, r}; r -= I_R;
            if (r < I_SG) return TrDesc{ws_gate, WSGU, g_ffn, 1024, 256, 2, 1024, r}; r -= I_SG;
            if (r < I_SG) return TrDesc{ws_up, WSGU, g_ffn, 1024, 256, 3, 1024, r}; r -= I_SG;
            if (r < I_SG) return TrDesc{ws_down, WSD, nullptr, 256, 1024, 0, 0, r}; r -= I_SG;
            if (r < 64 * I_E) { const int e = r / I_E; return TrDesc{w_gate + (size_t)e * 1024 * 256, WGU + (size_t)e * 512 * 1024, g_ffn, 1024, 256, 2, 1024, r % I_E}; } r -= 64 * I_E;
            if (r < 64 * I_E) { const int e = r / I_E; return TrDesc{w_up + (size_t)e * 1024 * 256, WGU + (size_t)e * 512 * 1024, g_ffn, 1024, 256, 3, 1024, r % I_E}; } r -= 64 * I_E;
            const int e = r / I_E; return TrDesc{w_down + (size_t)e * 256 * 1024, WD + (size_t)e * 1024 * 256, nullptr, 256, 1024, 0, 0, r % I_E};
        };
        for (int it = gw_; it < NIT; it += NGW) { const TrDesc d0 = decode(it); f32x4 v0[16]; tr_load(d0, v0, lane); tr_store(d0, v0, scr, lane); }
        for (int m = gw_; m < NTOK; m += 2 * NGW) rms_row2_bf16(x_in + (size_t)m * 1024, x_in + (size_t)(m + NGW) * 1024, g_mix, XN + (size_t)m * 1024, XN + (size_t)(m + NGW) * 1024, lane);
        for (int m = gw_; m < NMEM; m += NGW) rms_row_bf16(mem_in + (size_t)m * 1024, g_mem, MEMN + (size_t)m * 1024, lane);
        for (int i = gt_; i < NTOK * 32; i += NGT) { const int tok = i >> 5, j = i & 31;
            const float inv = exp2f(-(float)(2 * j) * (13.287712379549449f / 64.0f)); const float ang = (float)positions[tok] * inv; float s, c; sincosf(ang, &s, &c);
            ROPE[(size_t)i * 2] = c; ROPE[(size_t)i * 2 + 1] = s; }
        for (int i = gt_; i < MAXSLOT; i += NGT) SLOT[i] = -1;
        if (bx == 0 && wave == 0) { float a = lam_q1[lane] * lam_k1[lane], b2 = lam_q2[lane] * lam_k2[lane]; a = wave_sum(a); b2 = wave_sum(b2);
            if (lane == 0) ((float*)ctl)[CW_LAM] = expf(a) - expf(b2) + LAMBDA_INIT; }
    }
    SEAM(0);
#if MK_ONE_LAUNCH
    if (REPK(29)) { for (int xb_ = 0; xb_ < 10; ++xb_) GRID_BAR(); }
#endif

    if (IN(1)) for (int rep_ = 0; rep_ <= REPK(1); ++rep_) {
        { pg8::SrcPlain S{(const char*)XN, (const char*)WIN, 2048u, 2048u, 0, 0, 0, 0, 1, 128, 8, 1, G, vcu, 16, 128};
          EInproj8 e{U2, Qb, Kb, VT, ROPE}; pg8::gemm_phase(lds, S, e); }
    }
    SEAM(1);

    if (IN(2)) for (int rep_ = 0; rep_ <= REPK(2); ++rep_) {
        { SrcToep S{(const char*)U2, (const char*)KD, G, vcu, 16, -2048}; ESsmT8 e{YINTRA}; pg8::gemm_phase(lds, S, e); }
        { pg8::SrcPlain S{(const char*)U2, (const char*)WST, 2048u, 2048u, (size_t)NTOK * 32, (size_t)256 * 2048, 0, 0, 1, 2, 1, 32, G, vcu, 16, 128};
          ESsmS8 e{SST}; pg8::gemm_phase(lds, S, e); }
        constexpr int N_C = 16 * 4, N_D = 8 * 8;
        for (int i = (vcu + 192) & 255; i < N_C + N_D; i += G) { int r = i;
            if (r < N_C) { const int mt = r >> 2, nt = r & 3;
                UPlain u{(const char*)(MEMN + (size_t)mt * 128 * 1024), (const char*)(WKX + (size_t)nt * 256 * 1024), 2048u, 2048u, 16, 256};
                EPlain e{KX + (size_t)mt * 128 * 1024 + nt * 256, (size_t)1024, nullptr, 1.0f, 256}; gemm_unit(lds, u, e); }
            else { r -= N_C; const int b = r >> 3, mt = r & 7;
                UPlain u{(const char*)(WVX + (size_t)mt * 128 * 1024), (const char*)(MEMN + (size_t)b * 256 * 1024), 2048u, 2048u, 16, 256};
                EPlain e{VXT + ((size_t)(b * 1024 + mt * 128)) * 256, (size_t)256, nullptr, 1.0f, 256}; gemm_unit(lds, u, e); }
        }
    }
    SEAM(2);

    if (IN(3)) for (int rep_ = 0; rep_ <= REPK(3); ++rep_) {
        PHASE_TID();
        if (wave == 0) for (int i = vcu * 64 + lane; i < 8 * 32 * 64; i += G * 64) { const int p = i & 63, g = (i >> 6) & 31, b = i >> 11;
            const float dt = expf(log_dt[g]); float ar, ai; ssm_pow(a_re[g * 64 + p], a_im[g * 64 + p], dt, 64.0f, ar, ai);
            float xr = 0.f, xi = 0.f; const size_t base = ((size_t)g * 512 + b * 64) * 128 + p;
            for (int j0 = 0; j0 < 64; j0 += 16) { float sr_[16], si_[16];
#pragma unroll
                for (int j = 0; j < 16; ++j) { sr_[j] = SST[base + (size_t)(j0 + j) * 128]; si_[j] = SST[base + (size_t)(j0 + j) * 128 + 64]; }
#pragma unroll
                for (int j = 0; j < 16; ++j) { const size_t o = base + (size_t)(j0 + j) * 128;
                    EST[o] = (bf16_t)(pk2(xr, 0.f) & 0xffffu); EST[o + 64] = (bf16_t)(pk2(xi, 0.f) & 0xffffu);
                    const float nr = ar * xr - ai * xi + sr_[j], ni = ar * xi + ai * xr + si_[j]; xr = nr; xi = ni; } } }
        const float lam = ((const float*)ctl)[CW_LAM];
        const rsrc_t wsr = __builtin_amdgcn_make_buffer_rsrc(ws, 0, 0x20000000, 0x00020000);
        for (int pi = vcu; pi < 256; pi += G) { const int bh = pi >> 3, s = pi & 7, b = bh >> 2, h = bh & 3;
#pragma unroll 1
            for (int uu = 0; uu < 2; ++uu) { if (rep_ == 0) attn_unit3<0>(lds, wsr, ws, b, h, uu ? s : 15 - s, lam, g_sub, bx); else attn_unit3<PROBE_VAR>(lds, wsr, ws, b, h, uu ? s : 15 - s, lam, g_sub, bx); } }
    }
    SEAM(3);

    if (IN(4)) for (int rep_ = 0; rep_ <= REPK(4); ++rep_) {
        for (int i = vcu; i < 32 * 16; i += G) { const int g = i >> 4, mt = (i >> 2) & 3, pn = i & 3;
            UPlain u{(const char*)(EST + ((size_t)g * 512 + mt * 128) * 128), (const char*)(WYT + ((size_t)g * 1024 + pn * 256) * 128), 256u, 256u, 2, 256};
            EYstate e{g, mt, pn, YINTRA, U2, d_skip, YG}; gemm_unit(lds, u, e); }
    }
    SEAM(4);

    if (IN(5)) for (int rep_ = 0; rep_ <= REPK(5); ++rep_) {
        pg8::SrcPlain S{(const char*)YG, (const char*)WGLU, 1024u, 1024u, 0, 0, 0, 0, 1, 128, 2, 1, G, vcu, 8, 128};
        EGlu8 e{YG, YCAT, rep_ ? (float*)(ws + WS_O1S) : SSQ0}; pg8::gemm_phase(lds, S, e);
    }
    SEAM(5);

    if (IN(6)) for (int rep_ = 0; rep_ <= REPK(6); ++rep_) {
        pg8::SrcPlain S{(const char*)YCAT, (const char*)WOUT, 2048u, 2048u, 0, 0, 0, 0, 1, 128, 4, 1, G, vcu, 16, 128};
        EOut8 e{x_in, HB, SSQ0, rep_ ? (float*)(ws + WS_O1S) : SSQ1}; pg8::gemm_phase(lds, S, e);
    }
    SEAM(6);

    if (IN(7)) for (int rep_ = 0; rep_ <= REPK(7); ++rep_) {
        pg8::SrcPlain S{(const char*)HB, (const char*)WQX, 2048u, 2048u, 0, 0, 0, 0, 1, 128, 4, 1, G, vcu, 16, 128};
        EPlain8 e{QX, (size_t)1024, 0, 0, 1, SSQ1, CXQ}; pg8::gemm_phase(lds, S, e);
    }
    SEAM(7);

    if (IN(8)) for (int rep_ = 0; rep_ <= REPK(8); ++rep_) {
        pg8::SrcPlain S{(const char*)QX, (const char*)KX, 2048u, 2048u, (size_t)SEQ * 2048, (size_t)256 * 2048, 512, 512, 4, 16, 1, 32, G, vcu, 4, 128};
        ESoftmax8 e{PX, (LAS float*)(lds + LDS_SCR8)}; pg8::gemm_phase(lds, S, e);
    }
    SEAM(8);

    if (IN(9)) for (int rep_ = 0; rep_ <= REPK(9); ++rep_) {
        pg8::SrcPlain S{(const char*)PX, (const char*)VXT, 2048u, 512u, (size_t)SEQ * 2048, (size_t)1024 * 512, 512, (size_t)256 * 512, 4, 16, 1, 32, G, vcu, 4, 128};
        EPlain8 e{OX, (size_t)1024, (size_t)SEQ * 1024, 256, 4, nullptr, 1.0f}; pg8::gemm_phase(lds, S, e);
    }
    SEAM(9);

    if (IN(10)) for (int rep_ = 0; rep_ <= REPK(10); ++rep_) {
        pg8::SrcPlain S{(const char*)OX, (const char*)WOX, 2048u, 2048u, 0, 0, 0, 0, 1, 128, 4, 1, G, vcu, 16, 128};
        EWo8 e{HB, rep_ ? (bf16_t*)(ws + WS_PX) : HB, rep_ ? (float*)(ws + WS_O1S) : SSQ2}; pg8::gemm_phase(lds, S, e);
    }
    SEAM(10);


    LAS int* lhist = (LAS int*)(lds + LDS_TAB);
    if (IN(12)) for (int rep_ = 0; rep_ <= REPK(12); ++rep_) {
        PHASE_TID();
        for (int i = gt_; i < MAXSLOT; i += NGT) { ((float*)(ws + WS_SLOTW))[i] = 0.f; ((float*)(ws + WS_SLOTRS))[i] = 0.f; }
        for (int vb = bx; vb < 256; vb += G) {
            if (tid < 64) lhist[tid] = 0;
            { UPlain u{(const char*)(HB + (size_t)vb * 128 * 1024), (const char*)WR, 2048u, 2048u, 16, 64};
              ELdsF32 e{(LAS float*)(lds + LDS_SCR), SSQ2 + vb * 128}; gemm_unit64(lds, u, e); }
            __syncthreads();
            for (int i = 0; i < 16; ++i) { const int t = vb * 128 + wave * 16 + i;
                const float sc = 1.0f / (1.0f + expf(-((const LAS float*)(lds + LDS_SCR))[(wave * 16 + i) * 64 + lane])); const float biased = sc + router_bias[lane];
                const float m1 = max8_dpp(biased);
                const unsigned long long bl = __ballot(biased == m1); const unsigned gm = (unsigned)(bl >> (8 * (lane >> 3))) & 0xffu; const int first = __ffs((int)gm) - 1;
                const float m2 = max8_dpp(((lane & 7) == first) ? -INFINITY : biased);
                float cur = m1 + m2; unsigned selmask = 0u;
#pragma unroll
                for (int it = 0; it < 4; ++it) { const float mx = wave_max_dpp(cur); const unsigned long long b2 = __ballot(cur == mx); const int gsel = (__ffsll((long long)b2) - 1) >> 3; selmask |= 1u << gsel; if ((lane >> 3) == gsel) cur = -INFINITY; }
                float masked = ((selmask >> (lane >> 3)) & 1u) ? biased : -INFINITY; float wsum = 0.f, myw = 0.f; int mye = 0;
#pragma unroll
                for (int k = 0; k < 8; ++k) { const float mx = wave_max_dpp(masked); const unsigned long long b2 = __ballot(masked == mx); const int e = __ffsll((long long)b2) - 1;
                    const float w = __uint_as_float(__builtin_amdgcn_readlane(__float_as_uint(sc), __builtin_amdgcn_readfirstlane(e))); wsum += w; if (lane == k) { mye = e; myw = w; } if (lane == e) masked = -INFINITY; }
                if (lane < 8) { EIDX[t * 8 + lane] = mye; GW[t * 8 + lane] = myw / wsum * 2.5f; (void)__hip_atomic_fetch_add(&lhist[mye], 1, __ATOMIC_RELAXED, __HIP_MEMORY_SCOPE_WORKGROUP); } }
            __syncthreads();
            if (tid < 64) { const int c = lhist[tid]; BLKHIST[vb * 64 + tid] = c; atomicAdd((rep_ ? (int*)(ws + WS_O1S) : CNT) + (vb >= QVB(2) ? 2 : (vb >= QVB(1) ? 1 : 0)) * 64 + tid, c); }
            __syncthreads();
        }
    }
    SEAM(12);

    if (IN(13)) for (int rep_ = 0; rep_ <= REPK(13); ++rep_) {
        PHASE_TID();
        for (int vb = bx; vb < 256; vb += G) {
            if (tid < NQ * 64) lhist[512 + tid] = (CNT[tid] + 255) & ~255;
            __syncthreads();
            if (tid <= NQ * 64) { int s = 0; for (int e = 0; e < tid; ++e) s += lhist[512 + e]; lhist[128 + tid] = s; }
            __syncthreads();
            { const int qv = vb >= QVB(2) ? 2 : (vb >= QVB(1) ? 1 : 0), e = tid & 63, part = tid >> 6; int off = 0;
              for (int v = QVB(qv) + part; v < vb; v += 8) off += BLKHIST[v * 64 + e];
              lhist[512 + tid] = off;
              __syncthreads();
              if (tid < 64) { int s = lhist[128 + qv * 64 + tid];
#pragma unroll
                  for (int k = 0; k < 8; ++k) s += lhist[512 + k * 64 + tid];
                  lhist[64 + tid] = s; } }
            __syncthreads();
            for (int i = 0; i < 16; ++i) { const int t = vb * 128 + wave * 16 + i;
                if (lane < 8) { const int e = EIDX[t * 8 + lane]; const int pos = __hip_atomic_fetch_add(&lhist[64 + e], 1, __ATOMIC_RELAXED, __HIP_MEMORY_SCOPE_WORKGROUP); SLOT[pos] = t * 8 + lane; ((float*)(ws + WS_SLOTW))[pos] = GW[t * 8 + lane]; ((float*)(ws + WS_SLOTRS))[pos] = rsqrtf(SSQ2[t] * (1.0f / 1024.0f) + EPS); } }
            __syncthreads();
        }
    }
    SEAM(13);

    if (hi_ > 14) {
        PHASE_TID();
        if (tid < NQ * 64) lhist[512 + tid] = (CNT[tid] + 255) & ~255;
        __syncthreads();
        if (tid <= NQ * 64) { int s = 0; for (int e = 0; e < tid; ++e) s += lhist[512 + e]; lhist[128 + tid] = s; }
        __syncthreads();
    }
#pragma unroll 1
    for (int q = 0; q <= NQ; ++q) {
        const int pa = 14 + 2 * q, pb = 15 + 2 * q;
        if (q < NQ && hi_ > 14) {
            int tid = threadIdx.x; asm volatile("" : "+v"(tid));
            __syncthreads();
            const int qb_ = lhist[128 + q * 64] >> 8, nt_ = (lhist[128 + (q + 1) * 64] >> 8) - qb_;
            for (int t = tid; t < nt_; t += 512) { int e = 0;
                for (int s = 32; s > 0; s >>= 1) if (lhist[128 + q * 64 + e + s] <= (qb_ + t) * 256) e += s;
                lhist[1024 + t] = e; }
            __syncthreads();
        }
        if (IN(pa)) for (int step = 0; step < 2; ++step) {
            const bool do_comb = (step == 0) == (((vcu >> 1) & 1) == 0);
            if (do_comb && q > 0) {
                PHASE_TID();
                const unsigned char* Yq = ws + WS_Y;
                LAS float* tsc = (LAS float*)(lds + wave * 4096);
                const int tk0 = QVB(q - 1) * 128, ntk = (QVB(q) - QVB(q - 1)) * 128;
                for (int m = gw_; m < ntk; m += NGW) { const int tok = tk0 + m; float* hr = H + (size_t)tok * 1024; f32x4 v[4]; float s = 0.f;
                    const bf16_t* hb = HB + (size_t)tok * 1024;
                    u32x2 wh[4];
#pragma unroll
                    for (int j = 0; j < 4; ++j) wh[j] = __builtin_nontemporal_load((const u32x2*)(hb + (lane + 64 * j) * 4));
                    u32x4 yr[9];
#pragma unroll
                    for (int k = 0; k < 8; ++k) yr[k] = __builtin_nontemporal_load((const u32x4*)(Yq + ((size_t)m * 8 + k) * 1024 + lane * 16));
                    yr[8] = __builtin_nontemporal_load((const u32x4*)(ws + WS_YSLO + (size_t)tok * 1024 + lane * 16));
                    float a16[16];
#pragma unroll
                    for (int c = 0; c < 16; ++c) a16[c] = 0.f;
#pragma unroll
                    for (int k = 0; k < 9; ++k)
#pragma unroll
                        for (int c = 0; c < 4; ++c) { const unsigned w = c == 0 ? yr[k].x : c == 1 ? yr[k].y : c == 2 ? yr[k].z : yr[k].w;
                            const f32x2_t lo = __builtin_amdgcn_cvt_pk_f32_fp8(w, false), hi2 = __builtin_amdgcn_cvt_pk_f32_fp8(w, true);
                            a16[4 * c] += lo[0]; a16[4 * c + 1] += lo[1]; a16[4 * c + 2] += hi2[0]; a16[4 * c + 3] += hi2[1]; }
#pragma unroll
                    for (int c = 0; c < 4; ++c) *(LAS f32x4*)(tsc + lane * 16 + 4 * c) = (f32x4){a16[4 * c], a16[4 * c + 1], a16[4 * c + 2], a16[4 * c + 3]} * (1.0f / YSC);
                    LDS_WAIT();
#pragma unroll
                    for (int j = 0; j < 4; ++j) { const f32x4 t = *(const LAS f32x4*)(tsc + (lane + 64 * j) * 4);
                        v[j][0] = t[0] + bflo(wh[j].x); v[j][1] = t[1] + bfhi(wh[j].x); v[j][2] = t[2] + bflo(wh[j].y); v[j][3] = t[3] + bfhi(wh[j].y); }
                    LDS_WAIT();
#pragma unroll
                    for (int j = 0; j < 4; ++j) s += (v[j][0] * v[j][0] + v[j][1] * v[j][1]) + (v[j][2] * v[j][2] + v[j][3] * v[j][3]);
                    const float rs = rsqrtf(wave_sum(s) * (1.0f / 1024.0f) + EPS);
#pragma unroll
                    for (int j = 0; j < 4; ++j) { const f32x4 gg = *(const f32x4*)(g_final + (lane + 64 * j) * 4); __builtin_nontemporal_store(v[j] * rs * gg, (f32x4*)(hr + (lane + 64 * j) * 4)); } }
                __syncthreads();
            }
#ifndef NO_GU
            if (!do_comb && q < NQ) {
                const int qbase = __builtin_amdgcn_readfirstlane(lhist[128 + q * 64]), t0 = qbase >> 8, t1 = __builtin_amdgcn_readfirstlane(lhist[128 + (q + 1) * 64]) >> 8;
                { SrcMoe<true> S{(const char*)HB, 2048u, SLOT, qbase, (const char*)WGU, 2048u, (size_t)512 * 2048, 2, lhist + 1024, t0, (t1 - t0) * 2, G, vcu, 16, 128};
                  EGateUp8 ep{(const float*)(ws + WS_SLOTW), (const float*)(ws + WS_SLOTRS), SSQ2, HID}; for (int rep_ = 0; rep_ <= REPK(14); ++rep_) pg8::gemm_phase(lds, S, ep); }
                if (q == 0) { pg8::SrcPlain S{(const char*)HB, (const char*)WSGU, 2048u, 2048u, 0, 0, 0, 0, 1, 128, 2, 1, G, vcu, 16, 128};
                  EGateUp8 ep{nullptr, nullptr, SSQ2, HIDS}; pg8::gemm_phase(lds, S, ep); }
            }
#endif
        }
        if (q < NQ) SEAM(pa);
#ifndef NO_DN
        if (IN(pb) && q < NQ) {
            const int qbase = __builtin_amdgcn_readfirstlane(lhist[128 + q * 64]), t0 = qbase >> 8, t1 = __builtin_amdgcn_readfirstlane(lhist[128 + (q + 1) * 64]) >> 8;
            { SrcMoe<false> S{(const char*)HID, 512u, SLOT, qbase, (const char*)WD, 512u, (size_t)1024 * 512, 4, lhist + 1024, t0, (t1 - t0) * 4, G, vcu, 4, 128};
              EDownY8 ep{SLOT, QVB(q) * 128 * 8, (bf16_t*)(ws + WS_Y)}; for (int rep_ = 0; rep_ <= REPK(15); ++rep_) pg8::gemm_phase(lds, S, ep); }
            if (q == 0) { pg8::SrcPlain S{(const char*)HIDS, (const char*)WSD, 512u, 512u, 0, 0, 0, 0, 1, 128, 4, 1, G, vcu, 4, 128};
              EShared8 ep{ws + WS_YSLO}; pg8::gemm_phase(lds, S, ep); }
        }
#endif
        if (q < NQ) SEAM(pb);
    }
#undef IN
#undef SEAM
}
#undef x_in
#undef mem_in
#undef positions
#undef g_mix
#undef w_in
#undef a_re
#undef a_im
#undef log_dt
#undef b_re
#undef b_im
#undef c_re
#undef c_im
#undef d_skip
#undef w_glu
#undef g_ssm_out
#undef lam_q1
#undef lam_k1
#undef lam_q2
#undef lam_k2
#undef g_sub
#undef w_out
#undef g_x
#undef g_mem
#undef wq_x
#undef wk_x
#undef wv_x
#undef wo_x
#undef g_ffn
#undef w_router
#undef router_bias
#undef w_gate
#undef w_up
#undef w_down
#undef ws_gate
#undef ws_up
#undef ws_down
#undef g_final
#undef H
#undef WIN
#undef WV
#undef WGLU
#undef WR
#undef WSD
#undef WOUT
#undef WQX
#undef WKX
#undef WVX
#undef WOX
#undef WSGU
#undef WGU
#undef WD
#undef WST
#undef WYT
#undef KD
#undef POWT
#undef BBAR
#undef ROPE
#undef MEMN
#undef KX
#undef VXT
#undef SST
#undef EST
#undef LOGIT
#undef EIDX
#undef GW
#undef SLOT
#undef XN
#undef YINTRA
#undef HB
#undef U2
#undef Qb
#undef Kb
#undef VT
#undef YCAT
#undef QX
#undef PX
#undef YG
#undef OX
#undef HID
#undef HIDS
#undef SSQ0
#undef SSQ1
#undef SSQ2
#undef BLKHIST
#undef CNT


extern "C" void kernel_launch(void* const* d_in, const int* in_sizes, int n_in, void* d_out, int out_size, void* d_ws, size_t ws_size, hipStream_t stream) {
    static int grid = 0;
    if (grid == 0) {
        if (n_in != 37 || out_size != NTOK * DM || ws_size < WS_END) { fprintf(stderr, "kernel_launch: unexpected problem (n_in %d out %d ws %zu)\n", n_in, out_size, ws_size); grid = -1; return; }
        int dev = 0, cus = 0, per_cu = 0;
        if (hipGetDevice(&dev) != hipSuccess || hipDeviceGetAttribute(&cus, hipDeviceAttributeMultiprocessorCount, dev) != hipSuccess) { grid = -1; return; }
        if (hipFuncSetAttribute((const void*)fwd_kernel, hipFuncAttributeMaxDynamicSharedMemorySize, LDS_BYTES) != hipSuccess) { fprintf(stderr, "kernel_launch: hipFuncSetAttribute failed\n"); grid = -1; return; }
        if (hipOccupancyMaxActiveBlocksPerMultiprocessor(&per_cu, (const void*)fwd_kernel, 512, LDS_BYTES) != hipSuccess || per_cu < 1) { fprintf(stderr, "kernel_launch: occupancy query says %d\n", per_cu); per_cu = 1; }
        (void)hipGetLastError();
        grid = cus;
    }
    if (grid < 0) return;
    (void)hipMemsetAsync((char*)d_ws + WS_CTL, 0, CTL_BYTES, stream);
    Args a{};
    for (int i = 0; i < 37; ++i) a.in[i] = d_in[i];
    a.out = (float*)d_out; a.ws = (unsigned char*)d_ws;
#if MK_ONE_LAUNCH
    a.ph_lo = 0; a.ph_hi = NPHASE;
    hipLaunchKernelGGL(fwd_kernel, dim3(grid), dim3(512), LDS_BYTES, stream, a);
#else
    for (int p = 0; p < NPHASE; ++p) { a.ph_lo = p; a.ph_hi = p + 1; hipLaunchKernelGGL(fwd_kernel, dim3(grid), dim3(512), LDS_BYTES, stream, a); }
#endif
}
```

```cpp
#include <hip/hip_runtime.h>
#include <cstdio>
#include <cstdint>

#ifndef MK_ONE_LAUNCH
#define MK_ONE_LAUNCH 1
#endif

#define GAS __attribute__((address_space(1)))
typedef unsigned short bf16_t;
typedef short bf16x8 __attribute__((ext_vector_type(8)));
typedef float f32x4 __attribute__((ext_vector_type(4)));
typedef float f32x16 __attribute__((ext_vector_type(16)));
typedef unsigned u32x4 __attribute__((ext_vector_type(4)));
typedef unsigned u32x2 __attribute__((ext_vector_type(2)));
typedef float f32x2_t __attribute__((ext_vector_type(2)));
typedef __bf16 bf16x2_t __attribute__((ext_vector_type(2)));

constexpr int NB = 8, SEQ = 4096, DM = 1024, NTOK = NB * SEQ;
constexpr int MEML = 256, NMEM = NB * MEML;
constexpr int NEXP = 64, TOPK = 8, DEXP = 256;
constexpr int NASSIGN = NTOK * TOPK;
constexpr int NQ = 3;
__host__ __device__ constexpr int QVB(int q) { return (q * 256) / 3; }
constexpr int QTOK = 86 * 128;
constexpr int MAXSLOT = NASSIGN + NQ * NEXP * 256;
constexpr int QSLOT = QTOK * TOPK + NEXP * 256;
constexpr float EPS = 1e-6f;
constexpr float LOG2E = 1.4426950408889634f;
constexpr float C2Q = 0.125f * LOG2E;
constexpr float CXQ = 0.0625f * LOG2E;
constexpr float LAMBDA_INIT = 0.2f;
constexpr float WSC8 = 64.0f, HSC8 = 8.0f;
constexpr float YSC = 32.0f;

constexpr size_t MiB = 1u << 20;
constexpr size_t WS_CTL = 0, CTL_BYTES = 1 * MiB;
constexpr int CW_BAR = 4096;
constexpr int CW_CNT = 8192;
constexpr int CW_LAM = 8512;
constexpr size_t WS_SSQP0 = 166 * MiB, WS_SSQP1 = 167 * MiB, WS_SSQP2 = 169 * MiB;
constexpr size_t CB_SSQ0 = 64 * 1024, CB_SSQ1 = 192 * 1024, CB_SSQ2 = 320 * 1024;
constexpr size_t CB_BLKHIST = 448 * 1024;
constexpr size_t WS_WIN = 1 * MiB;
constexpr size_t WS_WV = 4 * MiB;
constexpr size_t WS_WGLU = 5 * MiB;
constexpr size_t WS_WR = 5 * MiB + 512 * 1024;
constexpr size_t WS_WSD = 5 * MiB + 768 * 1024;
constexpr size_t WS_WOUT = 7 * MiB, WS_WQX = 9 * MiB, WS_WKX = 11 * MiB, WS_WVX = 13 * MiB, WS_WOX = 15 * MiB;
constexpr size_t WS_WSGU = 17 * MiB;
constexpr size_t WS_WGU = 18 * MiB;
constexpr size_t WS_WD = 82 * MiB;
constexpr size_t WS_WST = 496 * MiB;
constexpr size_t WS_WYT = 122 * MiB;
constexpr size_t WS_KD = 166 * MiB;
constexpr int KDG = 127 * 256;
constexpr size_t WS_ROPE = 131 * MiB;
constexpr size_t WS_MEMN = 139 * MiB, WS_KX = 143 * MiB, WS_VXT = 147 * MiB;
constexpr size_t WS_S = 151 * MiB;
constexpr size_t WS_E = 159 * MiB;
constexpr size_t WS_LOGIT = 163 * MiB;
constexpr size_t WS_POWT = 163 * MiB;
constexpr size_t WS_BBAR = 165 * MiB;
constexpr size_t WS_EIDX = 171 * MiB, WS_GW = 172 * MiB, WS_SLOT = 173 * MiB;
constexpr size_t WS_SLOTW = 146 * MiB + 512 * 1024, WS_SLOTRS = 148 * MiB + 512 * 1024;
constexpr size_t WS_A0 = 176 * MiB;
constexpr size_t WS_U2 = 240 * MiB;
constexpr size_t WS_Q = 272 * MiB, WS_K = 304 * MiB, WS_VT = 336 * MiB;
constexpr size_t WS_YCAT = 368 * MiB;
constexpr size_t WS_O1S = 464 * MiB;
constexpr size_t WS_QX = 272 * MiB;
constexpr size_t WS_PX = 368 * MiB;
constexpr size_t WS_YG = 432 * MiB;
constexpr size_t WS_OX = 432 * MiB;
constexpr size_t WS_HID = 240 * MiB;
constexpr size_t WS_HIDS = 292 * MiB;
constexpr size_t WS_Y = 308 * MiB;
constexpr size_t WS_IDX8 = 174 * MiB + 512 * 1024, WS_IDX1 = 175 * MiB, WS_SW1 = 147 * MiB + 896 * 1024, WS_SRS1 = 149 * MiB + 896 * 1024;
constexpr int LCAP = QTOK;
constexpr size_t WS_LSLOT = 400 * MiB, WS_LW = 410 * MiB, WS_LRS = 420 * MiB;
constexpr size_t WS_HB8 = 114 * MiB;
constexpr size_t WS_YSLO = 480 * MiB, WS_YSHI = 114 * MiB;
constexpr size_t WS_END = 512 * MiB;
static_assert(WS_HID + (size_t)QSLOT * 512 <= WS_HIDS && WS_SLOT + (size_t)MAXSLOT * 4 <= WS_A0 && WS_Y + (size_t)QTOK * 8 * 2048 <= WS_END, "moe map");

constexpr int LDS_GBUF = 49152;
constexpr int LDS_SCR = 2 * LDS_GBUF;
constexpr int LDS_SCR8 = 131072;
constexpr int LDS_TAB = 139264;
constexpr int LDS_MISC = 146432;
constexpr int LDS_BYTES = 147456;

__device__ __forceinline__ unsigned pk2(float lo, float hi) { f32x2_t v = {lo, hi}; bf16x2_t b = __builtin_convertvector(v, bf16x2_t); return __builtin_bit_cast(unsigned, b); }
__device__ __forceinline__ float bflo(unsigned w) { return __uint_as_float(w << 16); }
__device__ __forceinline__ float bfhi(unsigned w) { return __uint_as_float(w & 0xffff0000u); }
#define SHX(v, M) __builtin_bit_cast(float, __builtin_amdgcn_ds_swizzle(__builtin_bit_cast(int, (float)(v)), ((M) << 10) | 0x1f))
__device__ __forceinline__ float sh32_sum(float v) { auto rr = __builtin_amdgcn_permlane32_swap(__float_as_uint(v), __float_as_uint(v), false, false); return __uint_as_float(rr[0]) + __uint_as_float(rr[1]); }
__device__ __forceinline__ float sh32_max(float v) { auto rr = __builtin_amdgcn_permlane32_swap(__float_as_uint(v), __float_as_uint(v), false, false); return fmaxf(__uint_as_float(rr[0]), __uint_as_float(rr[1])); }
__device__ __forceinline__ float wave_sum(float v) { v += SHX(v, 1); v += SHX(v, 2); v += SHX(v, 4); v += SHX(v, 8); v += SHX(v, 16); return sh32_sum(v); }
__device__ __forceinline__ float wave_max(float v) { v = fmaxf(v, SHX(v, 1)); v = fmaxf(v, SHX(v, 2)); v = fmaxf(v, SHX(v, 4)); v = fmaxf(v, SHX(v, 8)); v = fmaxf(v, SHX(v, 16)); return sh32_max(v); }
#define DPPF(v, ctrl, rmask) __builtin_bit_cast(float, __builtin_amdgcn_update_dpp(__builtin_bit_cast(int, (float)(v)), __builtin_bit_cast(int, (float)(v)), (ctrl), (rmask), 0xF, false))
__device__ __forceinline__ float max8_dpp(float t) { t = fmaxf(t, DPPF(t, 0xB1, 0xF)); t = fmaxf(t, DPPF(t, 0x4E, 0xF)); t = fmaxf(t, DPPF(t, 0x141, 0xF)); return t; }
__device__ __forceinline__ float wave_max_dpp(float t) { t = max8_dpp(t); t = fmaxf(t, DPPF(t, 0x140, 0xF)); t = fmaxf(t, DPPF(t, 0x142, 0xA)); t = fmaxf(t, DPPF(t, 0x143, 0xC));
    return __uint_as_float(__builtin_amdgcn_readlane(__float_as_uint(t), 63)); }
#define LDS_WAIT() asm volatile("s_waitcnt lgkmcnt(0)" ::: "memory")


__device__ __forceinline__ int lane_id_v() { int l; asm volatile("v_mbcnt_lo_u32_b32 %0, -1, 0\n\tv_mbcnt_hi_u32_b32 %0, -1, %0" : "=v"(l)); return l; }
#define TID_OF(wv) (((int)(wv) << 6) | lane_id_v())
#define LAS __attribute__((address_space(3)))
#define XB_TMO      128
#define XB_XCNT(j)  (256  + 64 * (j))
#define XB_XSUB(j)  (1280 + 64 * (j))
#define XB_XGEN(j)  (2304 + 64 * (j))
#define XB_TOP      3328
#define XB_TOPGEN   3392
#define XCD_BAR_WORDS 3456
#define XB_SPIN_CAP (1u << 18)

__device__ __forceinline__ unsigned xb_ld(unsigned* p)              { return __hip_atomic_load(p, __ATOMIC_RELAXED, __HIP_MEMORY_SCOPE_AGENT); }
__device__ __forceinline__ unsigned xb_add(unsigned* p, unsigned v) { return __hip_atomic_fetch_add(p, v, __ATOMIC_RELAXED, __HIP_MEMORY_SCOPE_AGENT); }
__device__ __forceinline__ unsigned xb_xcc_id() { return (unsigned)__builtin_amdgcn_s_getreg((3 << 11) | 20) & 0xFu; }
#define XB_SPIN(cond, bar) do { unsigned _sp = 0; while (cond) { __builtin_amdgcn_s_sleep(1); \
    if ((++_sp & 255u) == 0u) { if (xb_ld(&(bar)[XB_TMO])) break; if (_sp > XB_SPIN_CAP) { atomicAdd(&(bar)[XB_TMO], 1u); break; } } } } while (0)

struct XcdBarrier {
    unsigned* bar; unsigned x; unsigned w;
    volatile LAS unsigned* st;
};

__device__ __forceinline__ XcdBarrier xcd_barrier_post(unsigned* bar, volatile LAS unsigned* st, unsigned wv) {
    XcdBarrier b; b.bar = bar; b.x = xb_xcc_id(); b.st = st; b.w = wv;
    if (TID_OF(b.w) == 0) (void)xb_add(&bar[XB_XCNT(b.x)], 1u);
    return b;
}
__device__ __forceinline__ void xcd_barrier_complete(unsigned* bar, unsigned x, unsigned& nloc, unsigned& nx) {
    const unsigned G = gridDim.x * gridDim.y * gridDim.z;
    unsigned sum, cnt, mine, sp = 0u;
    for (;;) {
        sum = 0u; cnt = 0u; mine = 0u;
#pragma unroll
        for (unsigned j = 0; j < 16; ++j) { const unsigned c = xb_ld(&bar[XB_XCNT(j)]); sum += c; cnt += (c > 0u) ? 1u : 0u; mine = (j == x) ? c : mine; }
        if (sum == G) break;
        __builtin_amdgcn_s_sleep(1);
        if ((++sp & 255u) == 0u) { if (xb_ld(&bar[XB_TMO])) break; if (sp > XB_SPIN_CAP) { atomicAdd(&bar[XB_TMO], 1u); break; } }
    }
    nloc = mine > 0u ? mine : 1u; nx = cnt > 0u ? cnt : 1u;
}

__device__ __forceinline__ void xcd_barrier(const XcdBarrier& b) {
    asm volatile("s_waitcnt vmcnt(0)" ::: "memory");
    __syncthreads();
    if (TID_OF(b.w) == 0) {
        unsigned* bar = b.bar;
        __builtin_amdgcn_s_waitcnt(0);
        unsigned nloc = b.st[0], nx = b.st[1];
        if (nloc == 0u) { xcd_barrier_complete(bar, b.x, nloc, nx); b.st[0] = nloc; b.st[1] = nx; }
        const unsigned old = xb_add(&bar[XB_XSUB(b.x)], 1u);
        const unsigned gen = old / nloc;
        if (old + 1u == (gen + 1u) * nloc) {
            __builtin_amdgcn_fence(__ATOMIC_RELEASE, "agent");
            asm volatile("s_waitcnt vmcnt(0)" ::: "memory");
            (void)xb_add(&bar[XB_TOP], 1u);
        }
        XB_SPIN(xb_ld(&bar[XB_TOP]) < (gen + 1u) * nx, bar);
        __builtin_amdgcn_fence(__ATOMIC_ACQUIRE, "agent");
        asm volatile("s_waitcnt vmcnt(0)" ::: "memory");
    }
    __syncthreads();
}


struct UPlain {
    const char* A; const char* B; unsigned lda, ldb; int nk; int nvalid;
    __device__ __forceinline__ const char* arow(int r) const { return A + (size_t)r * lda; }
    __device__ __forceinline__ const char* brow(int r) const { return B + (size_t)(r < nvalid ? r : 0) * ldb; }
    __device__ __forceinline__ u32x4 aload(const char* p, int c, int kt) const { return *(const u32x4*)(p + kt * 128 + c * 16); }
    __device__ __forceinline__ u32x4 bload(const char* p, int r, int c, int kt) const {
        u32x4 v = *(const u32x4*)(p + kt * 128 + c * 16); if (r >= nvalid) v = (u32x4){0u, 0u, 0u, 0u}; return v; }
};
struct UToep {
    const char* A; unsigned lda; const char* KD; int nk; int pn;
    __device__ __forceinline__ const char* arow(int r) const { return A + (size_t)r * lda; }
    __device__ __forceinline__ const char* brow(int r) const { const int n = pn * 256 + r; return KD + ((n >> 4) * 256 + (n & 15) * 16) * 2; }
    __device__ __forceinline__ u32x4 aload(const char* p, int c, int kt) const { return *(const u32x4*)(p + kt * 128 + c * 16); }
    __device__ __forceinline__ u32x4 bload(const char* p, int r, int c, int kt) const {
        const int n = pn * 256 + r, tp = n >> 4, s = kt * 4 + (c >> 1);
        u32x4 v = (u32x4){0u, 0u, 0u, 0u};
        if (s <= tp) v = *(const u32x4*)(p - s * 512 + (c & 1) * 16);
        return v; }
};

struct UGather { const char* HBp; const int* aid; const char* B; int nk;
    __device__ __forceinline__ const char* arow(int r) const { const int a = aid[r]; return HBp + (size_t)(a < 0 ? 0 : (a >> 3)) * 2048; }
    __device__ __forceinline__ const char* brow(int r) const { return B + (size_t)r * 2048; }
    __device__ __forceinline__ u32x4 aload(const char* p, int c, int kt) const { return *(const u32x4*)(p + kt * 128 + c * 16); }
    __device__ __forceinline__ u32x4 bload(const char* p, int r, int c, int kt) const { return *(const u32x4*)(p + kt * 128 + c * 16); } };

template <class U, class E>
__device__ __forceinline__ void gemm_unit_w(LAS unsigned char* lds, const U& u, E& e, int wv) {
    int tid = TID_OF(wv); asm volatile("" : "+v"(tid));
    const int lane = tid & 63;
    const int wid = __builtin_amdgcn_readfirstlane(tid >> 6);
    const int wr = wid >> 2, wc = wid & 3, fr = lane & 15, fq = lane >> 4;
    const int sr = tid >> 3, sc = tid & 7;
    const unsigned st = (unsigned)(sr * 128 + ((sc ^ ((sr >> 1) & 7)) << 4));
    const char* ap0 = u.arow(sr); const char* ap1 = u.arow(sr + 64);
    const char* bp0 = u.brow(sr); const char* bp1 = u.brow(sr + 64); const char* bp2 = u.brow(sr + 128); const char* bp3 = u.brow(sr + 192);
    const unsigned c0 = (unsigned)((fq ^ ((fr >> 1) & 7)) << 4), c1 = c0 ^ 64u;
    const unsigned aoff = (unsigned)((wr * 64 + fr) * 128);
    const unsigned boff = 16384u + (unsigned)((wc * 64 + fr) * 128);
    f32x4 acc[4][4];
#pragma unroll
    for (int m = 0; m < 4; ++m)
#pragma unroll
        for (int n = 0; n < 4; ++n) acc[m][n] = (f32x4){0.f, 0.f, 0.f, 0.f};
    const int nk = u.nk;
    u32x4 ra0 = u.aload(ap0, sc, 0), ra1 = u.aload(ap1, sc, 0);
    u32x4 rb0 = u.bload(bp0, sr, sc, 0), rb1 = u.bload(bp1, sr + 64, sc, 0), rb2 = u.bload(bp2, sr + 128, sc, 0), rb3 = u.bload(bp3, sr + 192, sc, 0);
    *(LAS u32x4*)(lds + st) = ra0; *(LAS u32x4*)(lds + st + 8192) = ra1;
    *(LAS u32x4*)(lds + 16384 + st) = rb0; *(LAS u32x4*)(lds + 16384 + st + 8192) = rb1;
    *(LAS u32x4*)(lds + 16384 + st + 16384) = rb2; *(LAS u32x4*)(lds + 16384 + st + 24576) = rb3;
    __syncthreads();
    for (int kt = 0; kt < nk; ++kt) {
        const unsigned cur = (unsigned)(kt & 1) * (unsigned)LDS_GBUF, nxt = (unsigned)LDS_GBUF - cur;
        const bool more = kt + 1 < nk;
        if (more) {
            ra0 = u.aload(ap0, sc, kt + 1); ra1 = u.aload(ap1, sc, kt + 1);
            rb0 = u.bload(bp0, sr, sc, kt + 1); rb1 = u.bload(bp1, sr + 64, sc, kt + 1); rb2 = u.bload(bp2, sr + 128, sc, kt + 1); rb3 = u.bload(bp3, sr + 192, sc, kt + 1);
        }
#pragma unroll
        for (int kk = 0; kk < 2; ++kk) {
            const unsigned ck = kk ? c1 : c0;
            bf16x8 af[4], bfr[4];
#pragma unroll
            for (int m = 0; m < 4; ++m) af[m] = *(const LAS bf16x8*)(lds + cur + aoff + m * 2048 + ck);
#pragma unroll
            for (int n = 0; n < 4; ++n) bfr[n] = *(const LAS bf16x8*)(lds + cur + boff + n * 2048 + ck);
#pragma unroll
            for (int m = 0; m < 4; ++m)
#pragma unroll
                for (int n = 0; n < 4; ++n) acc[m][n] = __builtin_amdgcn_mfma_f32_16x16x32_bf16(bfr[n], af[m], acc[m][n], 0, 0, 0);
        }
        if constexpr (E::HAS_MID) e.mid(kt, acc, wr, fr);
        if (more) {
            *(LAS u32x4*)(lds + nxt + st) = ra0; *(LAS u32x4*)(lds + nxt + st + 8192) = ra1;
            *(LAS u32x4*)(lds + nxt + 16384 + st) = rb0; *(LAS u32x4*)(lds + nxt + 16384 + st + 8192) = rb1;
            *(LAS u32x4*)(lds + nxt + 16384 + st + 16384) = rb2; *(LAS u32x4*)(lds + nxt + 16384 + st + 24576) = rb3;
        }
        __syncthreads();
    }
    e(acc, wr, wc, fr, fq);
}

template <class U, class E>
__device__ __forceinline__ void gemm_unit64_w(LAS unsigned char* lds, const U& u, E& e, int wv) {
    int tid = TID_OF(wv); asm volatile("" : "+v"(tid));
    const int lane = tid & 63;
    const int wid = __builtin_amdgcn_readfirstlane(tid >> 6);
    const int wr = wid >> 2, wc = wid & 3, fr = lane & 15, fq = lane >> 4;
    const int sr = tid >> 3, sc = tid & 7;
    const unsigned st = (unsigned)(sr * 128 + ((sc ^ ((sr >> 1) & 7)) << 4));
    const char* ap0 = u.arow(sr); const char* ap1 = u.arow(sr + 64);
    const char* bp0 = u.brow(sr);
    const unsigned c0 = (unsigned)((fq ^ ((fr >> 1) & 7)) << 4), c1 = c0 ^ 64u;
    const unsigned aoff = (unsigned)((wr * 64 + fr) * 128);
    const unsigned boff = 16384u + (unsigned)((wc * 16 + fr) * 128);
    f32x4 acc[4];
#pragma unroll
    for (int m = 0; m < 4; ++m) acc[m] = (f32x4){0.f, 0.f, 0.f, 0.f};
    const int nm = u.nk >> 2;
    u32x4 ra[4][2], rb[4];
#pragma unroll
    for (int s = 0; s < 4; ++s) { ra[s][0] = u.aload(ap0, sc, s); ra[s][1] = u.aload(ap1, sc, s); rb[s] = u.bload(bp0, sr, sc, s); }
    for (int mt = 0; mt < nm; ++mt) {
#pragma unroll
        for (int s = 0; s < 4; ++s) { *(LAS u32x4*)(lds + s * 24576 + st) = ra[s][0]; *(LAS u32x4*)(lds + s * 24576 + st + 8192) = ra[s][1]; *(LAS u32x4*)(lds + s * 24576 + 16384 + st) = rb[s]; }
        __syncthreads();
        if (mt + 1 < nm) {
#pragma unroll
            for (int s = 0; s < 4; ++s) { ra[s][0] = u.aload(ap0, sc, (mt + 1) * 4 + s); ra[s][1] = u.aload(ap1, sc, (mt + 1) * 4 + s); rb[s] = u.bload(bp0, sr, sc, (mt + 1) * 4 + s); }
        }
#pragma unroll
        for (int s = 0; s < 4; ++s)
#pragma unroll
            for (int kk = 0; kk < 2; ++kk) {
                const unsigned ck = kk ? c1 : c0;
                bf16x8 af[4];
#pragma unroll
                for (int m = 0; m < 4; ++m) af[m] = *(const LAS bf16x8*)(lds + s * 24576 + aoff + m * 2048 + ck);
                const bf16x8 bfr = *(const LAS bf16x8*)(lds + s * 24576 + boff + ck);
#pragma unroll
                for (int m = 0; m < 4; ++m) acc[m] = __builtin_amdgcn_mfma_f32_16x16x32_bf16(bfr, af[m], acc[m], 0, 0, 0);
            }
        __syncthreads();
    }
    e(acc, wr, wc, fr, fq);
}

#define EPI_LOOP for (int m = 0; m < 4; ++m) _Pragma("unroll") for (int n = 0; n < 4; ++n)
__device__ __forceinline__ void st4bf(bf16_t* p, f32x4 v) { u32x2 w; w.x = pk2(v[0], v[1]); w.y = pk2(v[2], v[3]); *(u32x2*)p = w; }

struct EInproj {
    static constexpr bool HAS_MID = false;
    int mt, nt; bf16_t* U2; bf16_t* Q; bf16_t* K; const float* rope;
    __device__ __forceinline__ void operator()(f32x4 (&acc)[4][4], int wr, int wc, int fr, int fq) {
#pragma unroll
        EPI_LOOP {
            const int tok = mt * 128 + wr * 64 + m * 16 + fr, col = nt * 256 + wc * 64 + n * 16 + 4 * fq; const f32x4 v = acc[m][n];
            if (nt < 2) { st4bf(U2 + ((size_t)(col >> 4) * NTOK + tok) * 16 + (col & 15), v); }
            else { const int which = nt >= 4, cc = col - (which ? 1024 : 512), j = (cc & 63) >> 1;
                const f32x4 cs = *(const f32x4*)(rope + ((size_t)tok * 32 + j) * 2);
                f32x4 o; o[0] = v[0] * cs[0] - v[1] * cs[1]; o[1] = v[1] * cs[0] + v[0] * cs[1]; o[2] = v[2] * cs[2] - v[3] * cs[3]; o[3] = v[3] * cs[2] + v[2] * cs[3];
                if (!which) o = o * C2Q;
                st4bf((which ? K : Q) + (size_t)tok * 512 + cc, o); }
        }
    }
};
struct EPlain {
    static constexpr bool HAS_MID = false;
    bf16_t* out; size_t ldc; const float* ssq; float cscale; int ncol;
    __device__ __forceinline__ void operator()(f32x4 (&acc)[4][4], int wr, int wc, int fr, int fq) {
#pragma unroll
        for (int m = 0; m < 4; ++m) { const int r = wr * 64 + m * 16 + fr; float rs = cscale; if (ssq) rs *= rsqrtf(ssq[r] * (1.0f / 1024.0f) + EPS);
#pragma unroll
            for (int n = 0; n < 4; ++n) { const int c = wc * 64 + n * 16 + 4 * fq; if (c < ncol) st4bf(out + (size_t)r * ldc + c, acc[m][n] * rs); } }
    }
};
struct EF32 {
    static constexpr bool HAS_MID = false;
    float* out; size_t ldc; const float* ssq; int ncol;
    __device__ __forceinline__ void operator()(f32x4 (&acc)[4][4], int wr, int wc, int fr, int fq) {
#pragma unroll
        for (int m = 0; m < 4; ++m) { const int r = wr * 64 + m * 16 + fr; float rs = 1.0f; if (ssq) rs = rsqrtf(ssq[r] * (1.0f / 1024.0f) + EPS);
#pragma unroll
            for (int n = 0; n < 4; ++n) { const int c = wc * 64 + n * 16 + 4 * fq; if (c < ncol) *(f32x4*)(out + (size_t)r * ldc + c) = acc[m][n] * rs; } }
    }
};
__device__ __forceinline__ void ssq_put(float s, float* slot, int fq) { s += SHX(s, 16); s = sh32_sum(s); if (fq == 0) *slot = s; }
template <int N> __device__ __forceinline__ float ssq_get(const float* p) { float s = 0.f;
#pragma unroll
    for (int j = 0; j < N / 4; ++j) { const f32x4 a4 = *(const f32x4*)(p + 4 * j); s += (a4[0] + a4[1]) + (a4[2] + a4[3]); }
    return s; }
struct ELdsF32 {
    LAS float* out; const float* ssq;
    __device__ __forceinline__ void operator()(f32x4 (&acc)[4], int wr, int wc, int fr, int fq) {
#pragma unroll
        for (int m = 0; m < 4; ++m) { const int r = wr * 64 + m * 16 + fr; const float rs = rsqrtf(ssq_get<16>(ssq + r * 16) * (1.0f / 1024.0f) + EPS);
            *(LAS f32x4*)(out + r * 64 + wc * 16 + 4 * fq) = acc[m] * rs; }
    }
};
struct ESsmT {
    static constexpr bool HAS_MID = false;
    int g, mt, pn; float* Y;
    __device__ __forceinline__ void operator()(f32x4 (&acc)[4][4], int wr, int wc, int fr, int fq) {
#pragma unroll
        EPI_LOOP { const int rr = mt * 128 + wr * 64 + m * 16 + fr, nn = pn * 256 + wc * 64 + n * 16 + 4 * fq;
            const int tok = (rr >> 6) * SEQ + (rr & 63) * 64 + (nn >> 4);
            *(f32x4*)(Y + (size_t)tok * 512 + g * 16 + (nn & 15)) = acc[m][n]; }
    }
};
__device__ __forceinline__ float gelu_tanh(float x) {
    const float u = 0.7978845608028654f * (x + 0.044715f * x * x * x);
    const float t = 1.0f - 2.0f / (1.0f + __expf(2.0f * u));
    return 0.5f * x * (1.0f + t);
}
struct EYstate {
    static constexpr bool HAS_MID = false;
    int g, mt, pn; const bf16_t* Y; const bf16_t* U2; const float* dskip; bf16_t* YG;
    __device__ __forceinline__ void operator()(f32x4 (&acc)[4][4], int wr, int wc, int fr, int fq) {
#pragma unroll
        EPI_LOOP { const int rr = mt * 128 + wr * 64 + m * 16 + fr, nn = pn * 256 + wc * 64 + n * 16 + 4 * fq;
            const int tok = (rr >> 6) * SEQ + (rr & 63) * 64 + (nn >> 4), c = nn & 15;
            const u32x2 yw = *(const u32x2*)(Y + ((size_t)g * NTOK + tok) * 16 + c); const f32x4 yi = (f32x4){bflo(yw.x), bfhi(yw.x), bflo(yw.y), bfhi(yw.y)};
            const f32x4 y = acc[m][n] + yi;
            f32x4 o; o[0] = gelu_tanh(y[0]); o[1] = gelu_tanh(y[1]); o[2] = gelu_tanh(y[2]); o[3] = gelu_tanh(y[3]);
            st4bf(YG + (size_t)tok * 512 + g * 16 + c, o); }
    }
};
__device__ __forceinline__ void ssq_add(float s, float* dst, int fq) { s += SHX(s, 16); s = sh32_sum(s); if (fq == 0) atomicAdd(dst, s); }
struct EGlu {
    static constexpr bool HAS_MID = false;
    int mt, nt; const bf16_t* YG; bf16_t* YCAT; float* ssq;
    __device__ __forceinline__ void operator()(f32x4 (&acc)[4][4], int wr, int wc, int fr, int fq) {
#pragma unroll
        for (int m = 0; m < 4; ++m) { const int tok = mt * 128 + wr * 64 + m * 16 + fr; float s = 0.f;
#pragma unroll
            for (int n = 0; n < 4; ++n) { const int col = nt * 256 + wc * 64 + n * 16 + 4 * fq;
                const u32x2 yw = *(const u32x2*)(YG + (size_t)tok * 512 + col); const f32x4 a = acc[m][n];
                f32x4 o; o[0] = bflo(yw.x) / (1.0f + __expf(-a[0])); o[1] = bfhi(yw.x) / (1.0f + __expf(-a[1])); o[2] = bflo(yw.y) / (1.0f + __expf(-a[2])); o[3] = bfhi(yw.y) / (1.0f + __expf(-a[3]));
                s += (o[0] * o[0] + o[1] * o[1]) + (o[2] * o[2] + o[3] * o[3]);
                st4bf(YCAT + (size_t)tok * 1024 + col, o); }
            ssq_add(s, ssq + tok, fq); }
    }
};
struct EOut {
    static constexpr bool HAS_MID = true;
    int mt, nt; const float* X; float* H; bf16_t* HB; const float* ssq_ssm; float* ssq1;
    __device__ __forceinline__ void mid(int kt, f32x4 (&acc)[4][4], int wr, int fr) {
        if (kt == 7) {
#pragma unroll
            for (int m = 0; m < 4; ++m) { const int tok = mt * 128 + wr * 64 + m * 16 + fr; const float rs = rsqrtf(ssq_ssm[tok] * (1.0f / 512.0f) + EPS);
#pragma unroll
                for (int n = 0; n < 4; ++n) acc[m][n] = acc[m][n] * rs; }
        }
    }
    __device__ __forceinline__ void operator()(f32x4 (&acc)[4][4], int wr, int wc, int fr, int fq) {
#pragma unroll
        for (int m = 0; m < 4; ++m) { const int tok = mt * 128 + wr * 64 + m * 16 + fr; float s = 0.f;
#pragma unroll
            for (int n = 0; n < 4; ++n) { const int col = nt * 256 + wc * 64 + n * 16 + 4 * fq; const size_t o = (size_t)tok * 1024 + col;
                const f32x4 h = *(const f32x4*)(X + o) + acc[m][n];
                s += (h[0] * h[0] + h[1] * h[1]) + (h[2] * h[2] + h[3] * h[3]);
                *(f32x4*)(H + o) = h; st4bf(HB + o, h); }
            ssq_add(s, ssq1 + tok, fq); }
    }
};
struct ESoftmax {
    static constexpr bool HAS_MID = false;
    bf16_t* P; size_t ldc; LAS float* red;
    __device__ __forceinline__ void operator()(f32x4 (&acc)[4][4], int wr, int wc, int fr, int fq) {
        float mx[4];
#pragma unroll
        for (int m = 0; m < 4; ++m) { float v = -INFINITY;
#pragma unroll
            for (int n = 0; n < 4; ++n) v = fmaxf(fmaxf(v, fmaxf(acc[m][n][0], acc[m][n][1])), fmaxf(acc[m][n][2], acc[m][n][3]));
            v = fmaxf(v, SHX(v, 16)); v = sh32_max(v);
            if (fq == 0) red[(wr * 64 + m * 16 + fr) * 4 + wc] = v; mx[m] = v; }
        __syncthreads();
        float sm[4];
#pragma unroll
        for (int m = 0; m < 4; ++m) { const f32x4 q = *(const LAS f32x4*)(red + (wr * 64 + m * 16 + fr) * 4); const float mm = fmaxf(fmaxf(q[0], q[1]), fmaxf(q[2], q[3])); float s = 0.f;
#pragma unroll
            for (int n = 0; n < 4; ++n) { f32x4 p; p[0] = __builtin_amdgcn_exp2f(acc[m][n][0] - mm); p[1] = __builtin_amdgcn_exp2f(acc[m][n][1] - mm); p[2] = __builtin_amdgcn_exp2f(acc[m][n][2] - mm); p[3] = __builtin_amdgcn_exp2f(acc[m][n][3] - mm);
                acc[m][n] = p; s += (p[0] + p[1]) + (p[2] + p[3]); }
            s += SHX(s, 16); s = sh32_sum(s);
            if (fq == 0) red[512 + (wr * 64 + m * 16 + fr) * 4 + wc] = s; sm[m] = s; }
        __syncthreads();
#pragma unroll
        for (int m = 0; m < 4; ++m) { const int r = wr * 64 + m * 16 + fr; const f32x4 q = *(const LAS f32x4*)(red + 512 + r * 4); const float inv = 1.0f / ((q[0] + q[1]) + (q[2] + q[3]));
#pragma unroll
            for (int n = 0; n < 4; ++n) st4bf(P + (size_t)r * ldc + wc * 64 + n * 16 + 4 * fq, acc[m][n] * inv); }
    }
};
struct EWo {
    static constexpr bool HAS_MID = false;
    int mt, nt; float* H; bf16_t* HB; float* ssq2;
    __device__ __forceinline__ void operator()(f32x4 (&acc)[4][4], int wr, int wc, int fr, int fq) {
#pragma unroll
        for (int m = 0; m < 4; ++m) { const int tok = mt * 128 + wr * 64 + m * 16 + fr; float s = 0.f;
#pragma unroll
            for (int n = 0; n < 4; ++n) { const int col = nt * 256 + wc * 64 + n * 16 + 4 * fq; const size_t o = (size_t)tok * 1024 + col;
                const f32x4 h = *(const f32x4*)(H + o) + acc[m][n];
                s += (h[0] * h[0] + h[1] * h[1]) + (h[2] * h[2] + h[3] * h[3]);
                *(f32x4*)(H + o) = h; st4bf(HB + o, h); }
            ssq_add(s, ssq2 + tok, fq); }
    }
};
struct EGateUp {
    static constexpr bool HAS_MID = false;
    const int* aid;
    int tok0; const float* ssq2; const float* gw; bf16_t* HID; int ct;
    __device__ __forceinline__ void operator()(f32x4 (&acc)[4][4], int wr, int wc, int fr, int fq) {
#pragma unroll
        for (int m = 0; m < 4; ++m) { const int r = wr * 64 + m * 16 + fr; int tok = tok0 + r; float w = 1.0f;
            if (aid) { const int a = aid[r]; tok = a < 0 ? 0 : (a >> 3); w = a < 0 ? 0.f : gw[a]; }
            const float rs = rsqrtf(ssq2[tok] * (1.0f / 1024.0f) + EPS);
#pragma unroll
            for (int p = 0; p < 2; ++p) { const f32x4 gg = acc[m][2 * p] * rs, uu = acc[m][2 * p + 1] * rs; f32x4 o;
#pragma unroll
                for (int i = 0; i < 4; ++i) o[i] = w * (gg[i] / (1.0f + __expf(-gg[i]))) * uu[i];
                st4bf(HID + (size_t)r * 256 + ct * 128 + wc * 32 + p * 16 + 4 * fq, o); } }
    }
};
struct EDownY {
    static constexpr bool HAS_MID = false;
    const int* aid; int aid0; bf16_t* Y; int ct;
    __device__ __forceinline__ void operator()(f32x4 (&acc)[4][4], int wr, int wc, int fr, int fq) {
#pragma unroll
        for (int m = 0; m < 4; ++m) { const int r = wr * 64 + m * 16 + fr; const int a = aid[r];
            if (a >= 0) { bf16_t* p = Y + (size_t)(a - aid0) * 1024 + ct * 256 + wc * 64 + 4 * fq;
#pragma unroll
                for (int n = 0; n < 4; ++n) st4bf(p + n * 16, acc[m][n]); } }
    }
};
struct EDownAcc {
    static constexpr bool HAS_MID = false;
    int tok0; float* H; int ct;
    __device__ __forceinline__ void operator()(f32x4 (&acc)[4][4], int wr, int wc, int fr, int fq) {
#pragma unroll
        EPI_LOOP { float* p = H + (size_t)(tok0 + wr * 64 + m * 16 + fr) * 1024 + ct * 256 + wc * 64 + n * 16 + 4 * fq; *(f32x4*)p = *(const f32x4*)p + acc[m][n]; }
    }
};

constexpr int AT_K = 0, AT_V = 16384, AT_VSZ = 128 * 136, AT_WS = AT_V + 3 * AT_VSZ, AT_STG = 69632;
__device__ __forceinline__ int crow(int r, int hi) { return (r & 3) + 8 * (r >> 2) + 4 * hi; }

typedef __amdgpu_buffer_rsrc_t rsrc_t;
__device__ __forceinline__ u32x4 bld16(rsrc_t r, unsigned voff, unsigned soff) { return __builtin_bit_cast(u32x4, __builtin_amdgcn_raw_buffer_load_b128(r, (int)voff, (int)soff, 0)); }
__device__ __forceinline__ void bst16(rsrc_t r, u32x4 v, unsigned voff, unsigned soff) { __builtin_amdgcn_raw_buffer_store_b128(__builtin_bit_cast(__attribute__((ext_vector_type(4))) unsigned, v), r, (int)voff, (int)soff, 0); }

#ifndef PROBE_VAR
#define PROBE_VAR 0
#endif
template <int VAR>
__device__ __forceinline__ void attn_unit(LAS unsigned char* lds, rsrc_t wsr, int b, int h, int qb, float lam, const float* gsub, int bx, int wv) {
    int tid = TID_OF(wv); asm volatile("" : "+v"(tid));
    const int lane = tid & 63, r32 = lane & 31, hi = lane >> 5;
    const int wid = __builtin_amdgcn_readfirstlane(tid >> 6);
    const int q0 = qb * 256 + wid * 32;
    const unsigned tokbase = (unsigned)b * SEQ;
    LAS float* wsc = (LAS float*)(lds + AT_WS) + wid * 32;
    const int sr = tid >> 3, sc = tid & 7;
    const unsigned kst = (unsigned)(sr * 128 + ((sc ^ ((sr >> 1) & 7)) << 4));
    const unsigned vst = (unsigned)(sr * 136 + sc * 16);
    const unsigned ksw = (unsigned)((r32 >> 1) & 7);
    const int nkt = 4 * qb + 4;
    const unsigned koff = (unsigned)(sr * 1024 + sc * 16), voff = (unsigned)(sr * (SEQ * 2) + sc * 16);
    const unsigned qoff = (unsigned)(r32 * 1024 + hi * 16);
    const unsigned s_o1 = (unsigned)WS_O1S + (unsigned)bx * (64u * 512u * 4u);
#pragma unroll 1
    for (int map = 0; map < 2; ++map) {
        const int mm = 2 * h + map;
        const unsigned s_q = (unsigned)WS_Q + ((tokbase + (unsigned)q0) * 512u + (unsigned)mm * 64u) * 2u;
        const unsigned s_k = (unsigned)WS_K + (tokbase * 512u + (unsigned)mm * 64u) * 2u;
        const unsigned s_v = (unsigned)WS_VT + ((unsigned)(b * 512 + h * 128) * (unsigned)SEQ) * 2u;
        bf16x8 qr[4];
#pragma unroll
        for (int s = 0; s < 4; ++s) qr[s] = __builtin_bit_cast(bf16x8, bld16(wsr, qoff + s * 32, s_q));
        f32x16 o[4];
#pragma unroll
        for (int d = 0; d < 4; ++d) o[d] = (f32x16){};
        float nmr = 0.f, lrun = 0.f;
        u32x4 rk = bld16(wsr, koff, s_k), rv0 = bld16(wsr, voff, s_v), rv1 = bld16(wsr, voff, s_v + 64u * SEQ * 2u);
        *(LAS u32x4*)(lds + AT_K + kst) = rk;
        *(LAS u32x2*)(lds + AT_V + vst) = (u32x2){rv0.x, rv0.y}; *(LAS u32x2*)(lds + AT_V + vst + 8) = (u32x2){rv0.z, rv0.w};
        *(LAS u32x2*)(lds + AT_V + vst + 64 * 136) = (u32x2){rv1.x, rv1.y}; *(LAS u32x2*)(lds + AT_V + vst + 64 * 136 + 8) = (u32x2){rv1.z, rv1.w};
        __syncthreads();
        bf16x8 pa[4];
#pragma unroll
        for (int i = 0; i < 4; ++i) pa[i] = (bf16x8){};
        auto H1 = [&](int kt) {
            const unsigned kb = AT_K + (unsigned)(kt & 1) * 8192u;
            f32x16 p0, p1;
#pragma unroll
            for (int r = 0; r < 16; ++r) { p0[r] = nmr; p1[r] = nmr; }
            { bf16x8 kf[8];
#pragma unroll
              for (int s = 0; s < 4; ++s) { const unsigned ch = ((unsigned)(2 * s + hi) ^ ksw) << 4;
                  kf[2 * s] = *(const LAS bf16x8*)(lds + kb + r32 * 128 + ch); kf[2 * s + 1] = *(const LAS bf16x8*)(lds + kb + (r32 + 32) * 128 + ch); }
              __builtin_amdgcn_sched_barrier(0);
#pragma unroll
              for (int s = 0; s < 4; ++s) { p0 = __builtin_amdgcn_mfma_f32_32x32x16_bf16(kf[2 * s], qr[s], p0, 0, 0, 0); p1 = __builtin_amdgcn_mfma_f32_32x32x16_bf16(kf[2 * s + 1], qr[s], p1, 0, 0, 0); } }
            if (kt * 64 + 63 > q0) {
                const int qpos = q0 + r32, kbase = kt * 64 + 4 * hi;
#pragma unroll
                for (int r = 0; r < 16; ++r) { const int key = kbase + (r & 3) + 8 * (r >> 2); if (key > qpos) p0[r] = -INFINITY; if (key + 32 > qpos) p1[r] = -INFINITY; }
            }
            float mx = __builtin_fmaxf(__builtin_fmaxf(p0[0], p1[0]), __builtin_fmaxf(p0[1], p1[1]));
#pragma unroll
            for (int r = 2; r < 16; r += 2) mx = __builtin_fmaxf(__builtin_fmaxf(mx, __builtin_fmaxf(p0[r], p1[r])), __builtin_fmaxf(p0[r + 1], p1[r + 1]));
            mx = sh32_max(mx);
            if (kt == 0 || __any(mx > 8.0f)) {
                const float dl = kt == 0 ? mx : fmaxf(mx, 0.f);
                const float alpha = __builtin_amdgcn_exp2f(-dl);
                nmr -= dl; lrun *= alpha;
#pragma unroll
                for (int r = 0; r < 16; ++r) { p0[r] -= dl; p1[r] -= dl; }
                if (hi == 0) wsc[r32] = alpha;
                LDS_WAIT();
#pragma unroll
                for (int g4 = 0; g4 < 4; ++g4) { const f32x4 a4 = *(const LAS f32x4*)(wsc + 8 * g4 + 4 * hi);
#pragma unroll
                    for (int d = 0; d < 4; ++d) { o[d][4 * g4] *= a4[0]; o[d][4 * g4 + 1] *= a4[1]; o[d][4 * g4 + 2] *= a4[2]; o[d][4 * g4 + 3] *= a4[3]; } }
            }
            float rsum = 0.f;
#pragma unroll
            for (int r = 0; r < 16; ++r) { if (VAR == 1) { p0[r] *= 0.5f; p1[r] *= 0.5f; } else { p0[r] = __builtin_amdgcn_exp2f(p0[r]); p1[r] = __builtin_amdgcn_exp2f(p1[r]); } rsum += p0[r] + p1[r]; }
            lrun += rsum;
            u32x4 w;
            w.x = pk2(p0[0], p0[1]); w.y = pk2(p0[2], p0[3]); w.z = pk2(p0[4], p0[5]); w.w = pk2(p0[6], p0[7]); pa[0] = __builtin_bit_cast(bf16x8, w);
            w.x = pk2(p0[8], p0[9]); w.y = pk2(p0[10], p0[11]); w.z = pk2(p0[12], p0[13]); w.w = pk2(p0[14], p0[15]); pa[1] = __builtin_bit_cast(bf16x8, w);
            w.x = pk2(p1[0], p1[1]); w.y = pk2(p1[2], p1[3]); w.z = pk2(p1[4], p1[5]); w.w = pk2(p1[6], p1[7]); pa[2] = __builtin_bit_cast(bf16x8, w);
            w.x = pk2(p1[8], p1[9]); w.y = pk2(p1[10], p1[11]); w.z = pk2(p1[12], p1[13]); w.w = pk2(p1[14], p1[15]); pa[3] = __builtin_bit_cast(bf16x8, w);
        };
        auto H2 = [&](int kt) {
            const unsigned vb = AT_V + (unsigned)(kt % 3) * (unsigned)AT_VSZ;
            u32x4 vf[2][4];
#define AT_VLOAD(buf, ks) _Pragma("unroll") for (int d = 0; d < 4; ++d) { const unsigned va = vb + (unsigned)((d * 32 + r32) * 136 + ((ks) * 16 + 4 * hi) * 2); \
                const u32x2 lo = *(const LAS u32x2*)(lds + va), hh = *(const LAS u32x2*)(lds + va + 16); vf[buf][d] = (u32x4){lo.x, lo.y, hh.x, hh.y}; }
            AT_VLOAD(0, 0)
            __builtin_amdgcn_sched_barrier(0);
#pragma unroll
            for (int ks = 0; ks < 4; ++ks) {
                if (ks == 0) { AT_VLOAD(1, 1) } else if (ks == 1) { AT_VLOAD(0, 2) } else if (ks == 2) { AT_VLOAD(1, 3) }
                __builtin_amdgcn_sched_barrier(0);
#pragma unroll
                for (int d = 0; d < 4; ++d) { if (VAR == 2) { o[d][0] += __uint_as_float(vf[ks & 1][d].x) + __uint_as_float(vf[ks & 1][d].z) + __builtin_bit_cast(f32x4, pa[ks])[0]; } else o[d] = __builtin_amdgcn_mfma_f32_32x32x16_bf16(pa[ks], __builtin_bit_cast(bf16x8, vf[ks & 1][d]), o[d], 0, 0, 0); }
                __builtin_amdgcn_sched_barrier(0);
            }
#undef AT_VLOAD
        };
        const bool lower = wid < 4 || VAR == 5;
#pragma unroll 1
        for (int kt = 0; kt < nkt; ++kt) {
            const bool more = kt + 1 < nkt;
            if (more && VAR != 4) { rk = bld16(wsr, koff, s_k + (unsigned)(kt + 1) * 65536u); rv0 = bld16(wsr, voff, s_v + (unsigned)(kt + 1) * 128u); rv1 = bld16(wsr, voff, s_v + 64u * SEQ * 2u + (unsigned)(kt + 1) * 128u); }
            if (!lower && kt > 0 && (kt - 1) * 64 <= q0 + 31) H2(kt - 1);
            if (kt * 64 <= q0 + 31) { H1(kt); if (lower) H2(kt); }
            if (more && VAR != 4) {
                const unsigned kbn = AT_K + 8192u - (unsigned)(kt & 1) * 8192u, vbn = AT_V + (unsigned)((kt + 1) % 3) * (unsigned)AT_VSZ;
                *(LAS u32x4*)(lds + kbn + kst) = rk;
                *(LAS u32x2*)(lds + vbn + vst) = (u32x2){rv0.x, rv0.y}; *(LAS u32x2*)(lds + vbn + vst + 8) = (u32x2){rv0.z, rv0.w};
                *(LAS u32x2*)(lds + vbn + vst + 64 * 136) = (u32x2){rv1.x, rv1.y}; *(LAS u32x2*)(lds + vbn + vst + 64 * 136 + 8) = (u32x2){rv1.z, rv1.w};
            }
            if (VAR != 3) __syncthreads();
        }
        if (!lower) { if ((nkt - 1) * 64 <= q0 + 31) H2(nkt - 1); }
        __syncthreads();
        float lt = sh32_sum(lrun);
        if (hi == 0) wsc[r32] = 1.0f / lt;
        LDS_WAIT();
#pragma unroll
        for (int g4 = 0; g4 < 4; ++g4) { const f32x4 a4 = *(const LAS f32x4*)(wsc + 8 * g4 + 4 * hi);
#pragma unroll
            for (int d = 0; d < 4; ++d) { o[d][4 * g4] *= a4[0]; o[d][4 * g4 + 1] *= a4[1]; o[d][4 * g4 + 2] *= a4[2]; o[d][4 * g4 + 3] *= a4[3]; } }
        LDS_WAIT();
        int tid2 = tid; asm volatile("" : "+v"(tid2));
        const unsigned soff1 = (unsigned)(tid2 * 256);
        if (map == 0) {
#pragma unroll
            for (int d = 0; d < 4; ++d)
#pragma unroll
                for (int g4 = 0; g4 < 4; ++g4) { const f32x4 t4 = (f32x4){o[d][4 * g4], o[d][4 * g4 + 1], o[d][4 * g4 + 2], o[d][4 * g4 + 3]}; bst16(wsr, __builtin_bit_cast(u32x4, t4), soff1 + (d * 64 + g4 * 16), s_o1); }
        } else {
            float ss[16];
#pragma unroll
            for (int r = 0; r < 16; ++r) ss[r] = 0.f;
#pragma unroll
            for (int d = 0; d < 4; ++d)
#pragma unroll
                for (int g4 = 0; g4 < 4; ++g4) { const f32x4 a = __builtin_bit_cast(f32x4, bld16(wsr, soff1 + (d * 64 + g4 * 16), s_o1));
#pragma unroll
                    for (int q = 0; q < 4; ++q) { const float v = a[q] - lam * o[d][4 * g4 + q]; o[d][4 * g4 + q] = v; ss[4 * g4 + q] += v * v; } }
#pragma unroll
            for (int r = 0; r < 16; ++r) { float s = ss[r]; s += SHX(s, 1); s += SHX(s, 2); s += SHX(s, 4); s += SHX(s, 8); s += SHX(s, 16);
                ss[r] = rsqrtf(s * (1.0f / 128.0f) + EPS) * (1.0f - LAMBDA_INIT); }
            LAS unsigned char* stg = lds + AT_STG + wid * (32 * 272);
#pragma unroll
            for (int d = 0; d < 4; ++d) { const int r32b = tid2 & 31, hib = (tid2 >> 5) & 1; const float gg = gsub[d * 32 + r32b];
#pragma unroll
                for (int r = 0; r < 16; ++r) { const int row = (r & 3) + 8 * (r >> 2) + 4 * hib;
                    *(LAS bf16_t*)(stg + row * 272 + (d * 32 + r32b) * 2) = (bf16_t)(pk2(o[d][r] * ss[r] * gg, 0.f) & 0xffffu); } }
            LDS_WAIT();
            const unsigned s_y = (unsigned)WS_YCAT + ((tokbase + (unsigned)q0) * 1024u + 512u + (unsigned)h * 128u) * 2u;
            const int lane2 = tid2 & 63;
            const unsigned yoff = (unsigned)((lane2 >> 4) * 2048 + (lane2 & 15) * 16);
#pragma unroll 2
            for (int i = 0; i < 8; ++i) { const int row = i * 4 + (lane2 >> 4), ch = lane2 & 15;
                const u32x4 v = *(const LAS u32x4*)(stg + row * 272 + ch * 16);
                if (VAR == 0) bst16(wsr, v, yoff, s_y + (unsigned)i * 8192u); }
            LDS_WAIT();
        }
    }
}


constexpr int AT2_V = 16384, AT2_WS = AT2_V + 2 * AT_VSZ, AT2_Q = 53248;
template <int VAR>
__device__ __forceinline__ void attn_unit2(LAS unsigned char* lds, rsrc_t wsr, int b, int h, int qb, float lam, const float* gsub, int bx, int wv) {
    int tid = TID_OF(wv); asm volatile("" : "+v"(tid));
    const int lane = tid & 63, r32 = lane & 31, hi = lane >> 5;
    const int wid = __builtin_amdgcn_readfirstlane(tid >> 6);
    const int q0 = qb * 256 + wid * 32;
    const unsigned tokbase = (unsigned)b * SEQ;
    LAS float* wsc = (LAS float*)(lds + AT2_WS) + wid * 32;
    LAS unsigned char* qs = lds + AT2_Q + wid * 4096 + lane * 16;
    const int sr = tid >> 3, sc = tid & 7;
    const unsigned kst = (unsigned)(sr * 128 + ((sc ^ ((sr >> 1) & 7)) << 4));
    const unsigned vst = (unsigned)(sr * 136 + sc * 16);
    const unsigned ksw = (unsigned)((r32 >> 1) & 7);
    const int nkt = 4 * qb + 4;
    const unsigned koff = (unsigned)(sr * 1024 + sc * 16), voff = (unsigned)(sr * (SEQ * 2) + sc * 16);
    const unsigned qoff = (unsigned)(r32 * 1024 + hi * 16);
    const unsigned s_o1 = (unsigned)WS_O1S + (unsigned)bx * (64u * 512u * 4u);
#pragma unroll 1
    for (int map = 0; map < 2; ++map) {
        const int mm = 2 * h + map;
        const unsigned s_q = (unsigned)WS_Q + ((tokbase + (unsigned)q0) * 512u + (unsigned)mm * 64u) * 2u;
        const unsigned s_k = (unsigned)WS_K + (tokbase * 512u + (unsigned)mm * 64u) * 2u;
        const unsigned s_v = (unsigned)WS_VT + ((unsigned)(b * 512 + h * 128) * (unsigned)SEQ) * 2u;
#pragma unroll
        for (int s = 0; s < 4; ++s) *(LAS u32x4*)(qs + s * 1024) = bld16(wsr, qoff + s * 32, s_q);
        f32x16 o[4];
#pragma unroll
        for (int d = 0; d < 4; ++d) o[d] = (f32x16){};
        float nmr = 0.f, lrun = 0.f;
        u32x4 rk = bld16(wsr, koff, s_k), rv0 = bld16(wsr, voff, s_v), rv1 = bld16(wsr, voff, s_v + 64u * SEQ * 2u);
        *(LAS u32x4*)(lds + AT_K + kst) = rk;
        *(LAS u32x2*)(lds + AT2_V + vst) = (u32x2){rv0.x, rv0.y}; *(LAS u32x2*)(lds + AT2_V + vst + 8) = (u32x2){rv0.z, rv0.w};
        *(LAS u32x2*)(lds + AT2_V + vst + 64 * 136) = (u32x2){rv1.x, rv1.y}; *(LAS u32x2*)(lds + AT2_V + vst + 64 * 136 + 8) = (u32x2){rv1.z, rv1.w};
        rk = bld16(wsr, koff, s_k + 65536u);
        *(LAS u32x4*)(lds + AT_K + 8192 + kst) = rk;
        __syncthreads();
        auto SQK = [&](f32x16& p0, f32x16& p1, int kt) {
            const unsigned kb = AT_K + (unsigned)(kt & 1) * 8192u;
#pragma unroll
            for (int r = 0; r < 16; ++r) { p0[r] = nmr; p1[r] = nmr; }
            if (VAR == 4) return;
            bf16x8 kf[8], qf[4];
#pragma unroll
            for (int s = 0; s < 4; ++s) { const unsigned ch = ((unsigned)(2 * s + hi) ^ ksw) << 4;
                kf[2 * s] = *(const LAS bf16x8*)(lds + kb + r32 * 128 + ch); kf[2 * s + 1] = *(const LAS bf16x8*)(lds + kb + (r32 + 32) * 128 + ch); qf[s] = *(const LAS bf16x8*)(qs + s * 1024); }
            __builtin_amdgcn_sched_barrier(0);
#pragma unroll
            for (int s = 0; s < 4; ++s) { p0 = __builtin_amdgcn_mfma_f32_32x32x16_bf16(kf[2 * s], qf[s], p0, 0, 0, 0); p1 = __builtin_amdgcn_mfma_f32_32x32x16_bf16(kf[2 * s + 1], qf[s], p1, 0, 0, 0); }
        };
        bf16x8 pa[4];
        auto SMX = [&](f32x16& p0, f32x16& p1, f32x16& n0, f32x16& n1, int kt) {
            if (kt * 64 + 63 > q0) {
                const int qpos = q0 + r32, kbase = kt * 64 + 4 * hi;
#pragma unroll
                for (int r = 0; r < 16; ++r) { const int key = kbase + (r & 3) + 8 * (r >> 2); if (key > qpos) p0[r] = -INFINITY; if (key + 32 > qpos) p1[r] = -INFINITY; }
            }
            float mx = __builtin_fmaxf(__builtin_fmaxf(p0[0], p1[0]), __builtin_fmaxf(p0[1], p1[1]));
#pragma unroll
            for (int r = 2; r < 16; r += 2) mx = __builtin_fmaxf(__builtin_fmaxf(mx, __builtin_fmaxf(p0[r], p1[r])), __builtin_fmaxf(p0[r + 1], p1[r + 1]));
            mx = sh32_max(mx);
            if (kt == 0 || __any(mx > 8.0f)) {
                const float dl = kt == 0 ? mx : fmaxf(mx, 0.f);
                const float alpha = __builtin_amdgcn_exp2f(-dl);
                nmr -= dl; lrun *= alpha;
#pragma unroll
                for (int r = 0; r < 16; ++r) { p0[r] -= dl; p1[r] -= dl; n0[r] -= dl; n1[r] -= dl; }
                if (hi == 0) wsc[r32] = alpha;
                LDS_WAIT();
#pragma unroll
                for (int g4 = 0; g4 < 4; ++g4) { const f32x4 a4 = *(const LAS f32x4*)(wsc + 8 * g4 + 4 * hi);
#pragma unroll
                    for (int d = 0; d < 4; ++d) { o[d][4 * g4] *= a4[0]; o[d][4 * g4 + 1] *= a4[1]; o[d][4 * g4 + 2] *= a4[2]; o[d][4 * g4 + 3] *= a4[3]; } }
            }
            float rsum = 0.f;
#pragma unroll
            for (int r = 0; r < 16; ++r) { if (VAR == 2) { p0[r] = p0[r] * 0.001f; p1[r] = p1[r] * 0.001f; } else { p0[r] = __builtin_amdgcn_exp2f(p0[r]); p1[r] = __builtin_amdgcn_exp2f(p1[r]); } rsum += p0[r] + p1[r]; }
            lrun += rsum;
            u32x4 w;
            w.x = pk2(p0[0], p0[1]); w.y = pk2(p0[2], p0[3]); w.z = pk2(p0[4], p0[5]); w.w = pk2(p0[6], p0[7]); pa[0] = __builtin_bit_cast(bf16x8, w);
            w.x = pk2(p0[8], p0[9]); w.y = pk2(p0[10], p0[11]); w.z = pk2(p0[12], p0[13]); w.w = pk2(p0[14], p0[15]); pa[1] = __builtin_bit_cast(bf16x8, w);
            w.x = pk2(p1[0], p1[1]); w.y = pk2(p1[2], p1[3]); w.z = pk2(p1[4], p1[5]); w.w = pk2(p1[6], p1[7]); pa[2] = __builtin_bit_cast(bf16x8, w);
            w.x = pk2(p1[8], p1[9]); w.y = pk2(p1[10], p1[11]); w.z = pk2(p1[12], p1[13]); w.w = pk2(p1[14], p1[15]); pa[3] = __builtin_bit_cast(bf16x8, w);
        };
        auto SPV = [&](int kt) {
            const unsigned vb = AT2_V + (unsigned)(kt & 1) * (unsigned)AT_VSZ;
            u32x4 vf[2][4];
#define AT_VLOAD(buf, ks) _Pragma("unroll") for (int d = 0; d < 4; ++d) { const unsigned va = vb + (unsigned)((d * 32 + r32) * 136 + ((ks) * 16 + 4 * hi) * 2); \
                const u32x2 lo = *(const LAS u32x2*)(lds + va), hh = *(const LAS u32x2*)(lds + va + 16); vf[buf][d] = (u32x4){lo.x, lo.y, hh.x, hh.y}; }
            AT_VLOAD(0, 0)
            __builtin_amdgcn_sched_barrier(0);
#pragma unroll
            for (int ks = 0; ks < 4; ++ks) {
                if (ks == 0) { AT_VLOAD(1, 1) } else if (ks == 1) { AT_VLOAD(0, 2) } else if (ks == 2) { AT_VLOAD(1, 3) }
                __builtin_amdgcn_sched_barrier(0);
#pragma unroll
                for (int d = 0; d < 4; ++d) o[d] = __builtin_amdgcn_mfma_f32_32x32x16_bf16(pa[ks], __builtin_bit_cast(bf16x8, vf[ks & 1][d]), o[d], 0, 0, 0);
                __builtin_amdgcn_sched_barrier(0);
            }
#undef AT_VLOAD
        };
        f32x16 pA0, pA1, pB0, pB1;
        SQK(pA0, pA1, 0);
#pragma unroll
        for (int r = 0; r < 16; ++r) { pB0[r] = 0.f; pB1[r] = 0.f; }
#define AT_STEP(P0, P1, N0, N1, kt) do { \
            const bool more1 = (kt) + 1 < nkt, more2 = (kt) + 2 < nkt; \
            if (more2) rk = bld16(wsr, koff, s_k + (unsigned)((kt) + 2) * 65536u); \
            if (more1) { rv0 = bld16(wsr, voff, s_v + (unsigned)((kt) + 1) * 128u); rv1 = bld16(wsr, voff, s_v + 64u * SEQ * 2u + (unsigned)((kt) + 1) * 128u); } \
            if ((kt) * 64 <= q0 + 31) { if (VAR != 5) SMX(P0, P1, N0, N1, (kt)); } \
            asm volatile("s_barrier" ::: "memory");        \
            if ((kt) * 64 <= q0 + 31) { if (VAR != 3) SPV(kt); } \
            if (more1 && ((kt) + 1) * 64 <= q0 + 31) SQK(N0, N1, (kt) + 1); \
            if (more2) *(LAS u32x4*)(lds + AT_K + (unsigned)((kt) & 1) * 8192u + kst) = rk; \
            if (more1) { const unsigned vbn = AT2_V + (unsigned)(((kt) + 1) & 1) * (unsigned)AT_VSZ; \
                *(LAS u32x2*)(lds + vbn + vst) = (u32x2){rv0.x, rv0.y}; *(LAS u32x2*)(lds + vbn + vst + 8) = (u32x2){rv0.z, rv0.w}; \
                *(LAS u32x2*)(lds + vbn + vst + 64 * 136) = (u32x2){rv1.x, rv1.y}; *(LAS u32x2*)(lds + vbn + vst + 64 * 136 + 8) = (u32x2){rv1.z, rv1.w}; } \
            __syncthreads(); } while (0)
        if (wid >= 4) asm volatile("s_barrier" ::: "memory");
#pragma unroll 1
        for (int kt = 0; kt < nkt; kt += 2) { AT_STEP(pA0, pA1, pB0, pB1, kt); AT_STEP(pB0, pB1, pA0, pA1, kt + 1); }
        if (wid < 4) asm volatile("s_barrier" ::: "memory");
#undef AT_STEP
        float lt = sh32_sum(lrun);
        if (hi == 0) wsc[r32] = 1.0f / lt;
        LDS_WAIT();
#pragma unroll
        for (int g4 = 0; g4 < 4; ++g4) { const f32x4 a4 = *(const LAS f32x4*)(wsc + 8 * g4 + 4 * hi);
#pragma unroll
            for (int d = 0; d < 4; ++d) { o[d][4 * g4] *= a4[0]; o[d][4 * g4 + 1] *= a4[1]; o[d][4 * g4 + 2] *= a4[2]; o[d][4 * g4 + 3] *= a4[3]; } }
        LDS_WAIT();
        int tid2 = tid; asm volatile("" : "+v"(tid2));
        const unsigned soff1 = (unsigned)(tid2 * 256);
        if (map == 0) {
#pragma unroll
            for (int d = 0; d < 4; ++d)
#pragma unroll
                for (int g4 = 0; g4 < 4; ++g4) { const f32x4 t4 = (f32x4){o[d][4 * g4], o[d][4 * g4 + 1], o[d][4 * g4 + 2], o[d][4 * g4 + 3]}; bst16(wsr, __builtin_bit_cast(u32x4, t4), soff1 + (d * 64 + g4 * 16), s_o1); }
        } else {
            float ss[16];
#pragma unroll
            for (int r = 0; r < 16; ++r) ss[r] = 0.f;
#pragma unroll
            for (int d = 0; d < 4; ++d)
#pragma unroll
                for (int g4 = 0; g4 < 4; ++g4) { const f32x4 a = __builtin_bit_cast(f32x4, bld16(wsr, soff1 + (d * 64 + g4 * 16), s_o1));
#pragma unroll
                    for (int q = 0; q < 4; ++q) { const float v = a[q] - lam * o[d][4 * g4 + q]; o[d][4 * g4 + q] = v; ss[4 * g4 + q] += v * v; } }
#pragma unroll
            for (int r = 0; r < 16; ++r) { float s = ss[r]; s += SHX(s, 1); s += SHX(s, 2); s += SHX(s, 4); s += SHX(s, 8); s += SHX(s, 16);
                ss[r] = rsqrtf(s * (1.0f / 128.0f) + EPS) * (1.0f - LAMBDA_INIT); }
            LAS unsigned char* stg = lds + AT2_Q + wid * (32 * 272);
#pragma unroll
            for (int d = 0; d < 4; ++d) { const int r32b = tid2 & 31, hib = (tid2 >> 5) & 1; const float gg = gsub[d * 32 + r32b];
#pragma unroll
                for (int r = 0; r < 16; ++r) { const int row = (r & 3) + 8 * (r >> 2) + 4 * hib;
                    *(LAS bf16_t*)(stg + row * 272 + (d * 32 + r32b) * 2) = (bf16_t)(pk2(o[d][r] * ss[r] * gg, 0.f) & 0xffffu); } }
            LDS_WAIT();
            const unsigned s_y = (unsigned)WS_YCAT + ((tokbase + (unsigned)q0) * 1024u + 512u + (unsigned)h * 128u) * 2u;
            const int lane2 = tid2 & 63;
            const unsigned yoff = (unsigned)((lane2 >> 4) * 2048 + (lane2 & 15) * 16);
#pragma unroll 2
            for (int i = 0; i < 8; ++i) { const int row = i * 4 + (lane2 >> 4), ch = lane2 & 15;
                const u32x4 v = *(const LAS u32x4*)(stg + row * 272 + ch * 16);
                if (VAR == 0) bst16(wsr, v, yoff, s_y + (unsigned)i * 8192u); }
            LDS_WAIT();
            __syncthreads();
        }
    }
}

constexpr int A3_K = 0, A3_V = 4 * 8192, A3_SV = 16384, A3_WS = A3_V + 3 * A3_SV, A3_QS = A3_WS + 2048;
typedef __attribute__((address_space(3))) const char* lds_cptr;
typedef short s16x4 __attribute__((ext_vector_type(4)));
__device__ __forceinline__ void glds16s(const void* sbase, unsigned voff, unsigned lds_dst) { unsigned keep;
    asm volatile("s_mov_b32 %0, m0\n\ts_mov_b32 m0, %3\n\ts_nop 0\n\tglobal_load_lds_dwordx4 %1, %2\n\ts_mov_b32 m0, %0" : "=&s"(keep) : "v"(voff), "s"(sbase), "s"(lds_dst) : "memory"); }
__device__ __forceinline__ s16x4 vtr(lds_cptr p) { return __builtin_bit_cast(s16x4, __builtin_amdgcn_ds_read_tr16_b64_v4i16((__attribute__((address_space(3))) s16x4*)p)); }
__device__ __forceinline__ bf16x8 kld(lds_cptr p) { return *(const __attribute__((address_space(3))) bf16x8*)p; }
#define A3_MX3(a, b, c) __builtin_fmaxf(__builtin_fmaxf((a), (b)), (c))
__device__ __forceinline__ float a3_rowmax(const f32x16& p0, const f32x16& p1) {
    float a = A3_MX3(p0[0], p0[1], p1[0]), b = A3_MX3(p0[2], p0[3], p1[1]); a = A3_MX3(a, p1[2], p1[3]);
#pragma unroll
    for (int r = 4; r < 16; r += 4) { a = A3_MX3(a, p0[r], p0[r + 1]); b = A3_MX3(b, p0[r + 2], p0[r + 3]); a = A3_MX3(a, p1[r], p1[r + 1]); b = A3_MX3(b, p1[r + 2], p1[r + 3]); }
    return sh32_max(__builtin_fmaxf(a, b)); }
__device__ __forceinline__ void a3_cmask(f32x16& p0, f32x16& p1, int jb, int qrel, int hi) {
    const int kb = 64 * jb + 4 * hi;
#pragma unroll
    for (int r = 0; r < 16; ++r) { const int kv = kb + (r & 3) + 8 * (r >> 2); if (kv > qrel) p0[r] = -INFINITY; if (kv + 32 > qrel) p1[r] = -INFINITY; } }
#ifndef A3_THR
#define A3_THR 8.0f
#endif
#define A3_SBAR() __builtin_amdgcn_sched_barrier(0)
#define A3_PIN(x) asm volatile("" : "+v"(x))
#define A3_MFMA(a, b, c) __builtin_amdgcn_mfma_f32_32x32x16_bf16(a, b, c, 0, 0, 0)
#define A3_WAIT_BAR(N) asm volatile("s_waitcnt vmcnt(" #N ") lgkmcnt(0)\n\ts_barrier" ::: "memory")
template <int VAR>
__device__ __forceinline__ void attn_unit3(LAS unsigned char* lds, rsrc_t wsr, const unsigned char* ws, int b, int h, int qb, float lam, const float* gsub, int bx, int wv) {
    int tid = TID_OF(wv); asm volatile("" : "+v"(tid));
    const int lane = tid & 63, r32 = lane & 31, hi = lane >> 5;
    const int wid = __builtin_amdgcn_readfirstlane(tid >> 6);
    const int q0 = qb * 256 + wid * 32, NT = 4 * qb + 4, qrel = wid * 32 + r32;
    const unsigned tokbase = (unsigned)b * SEQ;
    const unsigned lds0 = (unsigned)(size_t)lds;
    LAS float* wsf = (LAS float*)(lds + A3_WS) + wid * 64;
    const lds_cptr kp0 = (lds_cptr)lds + A3_K + hi * 1024 + r32 * 16;
    const lds_cptr vp0 = (lds_cptr)lds + A3_V + ((lane >> 4) & 1) * 32 + (lane & 3) * 8 + (4 * hi + ((lane & 15) >> 2)) * 64;
    const unsigned kvo = (unsigned)(lane * 1024 + wid * 16);
    const unsigned vvo = (unsigned)(((16 * (wid & 3) + (lane >> 2)) * 512 + (wid >> 2) * 32 + (lane & 3) * 8) * 2);
    const unsigned kdst = lds0 + A3_K + wid * 1024, vdst = lds0 + A3_V + wid * 1024;
    const unsigned qoff = (unsigned)(r32 * 1024 + hi * 16);
    const lds_cptr qs = (lds_cptr)lds + A3_QS + wid * 4096 + lane * 16;
    const unsigned s_o1 = (unsigned)WS_O1S + (unsigned)bx * (64u * 512u * 4u);
#pragma unroll 1
    for (int map = 0; map < 2; ++map) {
        const int mm = 2 * h + map;
        const unsigned char* Kg = ws + WS_K + ((size_t)tokbase * 512 + (size_t)mm * 64) * 2;
        const unsigned char* Vg = ws + WS_VT + ((size_t)tokbase * 512 + (size_t)h * 128) * 2;
        const unsigned s_q = (unsigned)WS_Q + ((tokbase + (unsigned)q0) * 512u + (unsigned)mm * 64u) * 2u;
#define DMA_K(t) glds16s(Kg + (size_t)(t) * 65536, kvo, (unsigned)__builtin_amdgcn_readfirstlane(kdst + (unsigned)((t) & 3) * 8192u))
#define DMA_V(t, slot) do { glds16s(Vg + (size_t)(t) * 65536, vvo, (unsigned)__builtin_amdgcn_readfirstlane(vdst + (unsigned)(slot))); \
                            glds16s(Vg + (size_t)(t) * 65536 + 128, vvo, (unsigned)__builtin_amdgcn_readfirstlane(vdst + (unsigned)(slot) + 8192u)); } while (0)
        DMA_K(0); DMA_V(0, 0); DMA_K(1); DMA_K(2);
        bf16x8 qa, qb;
        { u32x4 q4[4];
#pragma unroll
          for (int d0 = 0; d0 < 4; ++d0) q4[d0] = bld16(wsr, qoff + d0 * 32, s_q);
#pragma unroll
          for (int d0 = 0; d0 < 4; ++d0) *(LAS u32x4*)((LAS unsigned char*)qs + d0 * 1024) = q4[d0]; }
        float mhat = 0.f, l_reg = 0.f; f32x16 o[4];
#pragma unroll
        for (int d = 0; d < 4; ++d) o[d] = (f32x16){};
        f32x16 negm = (f32x16){}; A3_PIN(negm);
        bool resc = false;
        f32x16 pA0, pA1, pB0, pB1; bf16x8 kfa, kfb, kfc, kfd; s16x4 vlo[4], vhi[4]; u32x4 pw0, pw1, pw2, pw3;
        int sl_prev = 0, sl_cur = 0, sl_next = A3_SV;
#define ROT() do { sl_prev = sl_cur; sl_cur = sl_next; sl_next = (sl_next == 2 * A3_SV) ? 0 : sl_next + A3_SV; } while (0)
#define RESC() do { if (resc) { _Pragma("unroll") for (int d_ = 0; d_ < 4; ++d_) _Pragma("unroll") for (int r = 0; r < 16; ++r) o[d_][r] *= wsf[(r & 3) + 8 * (r >> 2) + 4 * hi]; } } while (0)
        A3_WAIT_BAR(0);
        { bf16x8 k8[8], qr[4];
#pragma unroll
          for (int d0 = 0; d0 < 4; ++d0) { k8[2 * d0] = kld(kp0 + d0 * 2048); k8[2 * d0 + 1] = kld(kp0 + d0 * 2048 + 512); qr[d0] = kld(qs + d0 * 1024); }
          pA0 = A3_MFMA(k8[0], qr[0], negm); pA1 = A3_MFMA(k8[1], qr[0], negm); pA0 = A3_MFMA(k8[2], qr[1], pA0); pA1 = A3_MFMA(k8[3], qr[1], pA1);
          pA0 = A3_MFMA(k8[4], qr[2], pA0); pA1 = A3_MFMA(k8[5], qr[2], pA1); pA0 = A3_MFMA(k8[6], qr[3], pA0); pA1 = A3_MFMA(k8[7], qr[3], pA1); }
        if (NT == 4) a3_cmask(pA0, pA1, 0, qrel, hi);
        { const float rm = a3_rowmax(pA0, pA1); mhat = rm;
#pragma unroll
          for (int r = 0; r < 16; ++r) { pA0[r] = __builtin_amdgcn_exp2f(pA0[r] - rm); pA1[r] = __builtin_amdgcn_exp2f(pA1[r] - rm); negm[r] = -rm; }
          A3_PIN(negm); }
        A3_WAIT_BAR(0);
        DMA_K(3); DMA_V(1, A3_SV); ROT();
        kfa = kld(kp0 + 8192); kfb = kld(kp0 + 8192 + 512); kfc = kld(kp0 + 8192 + 2048); kfd = kld(kp0 + 8192 + 2560);
        qa = kld(qs); qb = kld(qs + 1024);
#define PKW(P, i) pk2(P[i], P[(i) + 1])
#define PAF(k) __builtin_bit_cast(bf16x8, pw##k)
#define VFR(i) (bf16x8){vlo[i][0], vlo[i][1], vlo[i][2], vlo[i][3], vhi[i][0], vhi[i][1], vhi[i][2], vhi[i][3]}
#define VRD(sl, j) do { vlo[sl] = vtr(vp_ + (((j) & 3) * 4096 + ((j) >> 2) * 1024)); vhi[sl] = vtr(vp_ + (((j) & 3) * 4096 + ((j) >> 2) * 1024 + 512)); } while (0)
#define FO(f) (((f) >> 1) * 2048 + ((f) & 1) * 512)
#define GAPA(VR, MF, KF, QF, a0, a1, a2, a3, W0, W1, PW) do { VR; A3_SBAR(); MF; KF; QF; sacc += a0; sacc += a1; sacc += a2; sacc += a3; W0; W1; A3_PIN(PW); A3_PIN(sacc); A3_SBAR(); } while (0)
#define GAPB(MF, VR, X, i) do { MF; VR; X[i] = __builtin_amdgcn_exp2f(X[i]); X[(i) + 1] = __builtin_amdgcn_exp2f(X[(i) + 1]); A3_PIN(X); A3_SBAR(); } while (0)
#define STEP(C0, C1, P0, P1, t, MASK, GK, GV, GL) do { A3_SBAR(); \
        const lds_cptr vp_ = vp0 + sl_prev; const lds_cptr kc_ = kp0 + ((t) & 3) * 8192, kn_ = kp0 + (((t) + 1) & 3) * 8192; \
        float sacc = P0[0] + P0[1]; \
        GAPA((void)0,   C0 = A3_MFMA(kfa, qa, negm), kfa = kld(kc_ + FO(4)), (void)0,              P0[2], P0[3], P0[4], P0[5],     pw0[0] = PKW(P0, 0),  pw0[1] = PKW(P0, 2),  pw0); \
        GAPA((void)0,   C1 = A3_MFMA(kfb, qa, negm), kfb = kld(kc_ + FO(5)), qa = kld(qs + 2048),  P0[6], P0[7], P0[8], P0[9],     pw0[2] = PKW(P0, 4),  pw0[3] = PKW(P0, 6),  pw0); \
        GAPA((void)0,   C0 = A3_MFMA(kfc, qb, C0),   kfc = kld(kc_ + FO(6)), (void)0,              P0[10], P0[11], P0[12], P0[13], pw1[0] = PKW(P0, 8),  pw1[1] = PKW(P0, 10), pw1); \
        GAPA((void)0,   C1 = A3_MFMA(kfd, qb, C1),   kfd = kld(kc_ + FO(7)), qb = kld(qs + 3072),  P0[14], P0[15], P1[0], P1[1],   pw1[2] = PKW(P0, 12), pw1[3] = PKW(P0, 14), pw1); \
        GAPA(VRD(0, 0), C0 = A3_MFMA(kfa, qa, C0),   if (GL) kfa = kld(kn_ + FO(0)), (void)0,      P1[2], P1[3], P1[4], P1[5],     pw2[0] = PKW(P1, 0),  pw2[1] = PKW(P1, 2),  pw2); \
        GAPA(VRD(1, 1), C1 = A3_MFMA(kfb, qa, C1),   if (GL) kfb = kld(kn_ + FO(1)), if (GL) qa = kld(qs),        P1[6], P1[7], P1[8], P1[9],     pw2[2] = PKW(P1, 4),  pw2[3] = PKW(P1, 6),  pw2); \
        GAPA(VRD(2, 2), C0 = A3_MFMA(kfc, qb, C0),   if (GL) kfc = kld(kn_ + FO(2)), (void)0,      P1[10], P1[11], P1[12], P1[13], pw3[0] = PKW(P1, 8),  pw3[1] = PKW(P1, 10), pw3); \
        GAPA(VRD(3, 3), C1 = A3_MFMA(kfd, qb, C1),   if (GL) kfd = kld(kn_ + FO(3)), if (GL) qb = kld(qs + 1024), P1[14], P1[15], 0.f, 0.f,       pw3[2] = PKW(P1, 12), pw3[3] = PKW(P1, 14), pw3); \
        l_reg += sacc; \
        if (GK) DMA_K((t) + 3); if (GV) DMA_V((t) + 1, sl_next); \
        if (MASK) { const int jb_ = (t) - (NT - 4); if (jb_ >= 0) a3_cmask(C0, C1, jb_, qrel, hi); } \
        { const float rm = a3_rowmax(C0, C1); resc = false; \
          if (__builtin_expect(__any(rm > A3_THR), 0)) { const float dl = __builtin_fmaxf(rm, 0.f); mhat += dl; \
              _Pragma("unroll") for (int r = 0; r < 16; ++r) { C0[r] -= dl; C1[r] -= dl; negm[r] = -mhat; } \
              A3_PIN(negm); const float f = __builtin_amdgcn_exp2f(-dl); l_reg *= f; if (hi == 0) wsf[r32] = f; resc = true; } } \
        A3_SBAR(); \
        GAPB(o[0] = A3_MFMA(PAF(0), VFR(0), o[0]), VRD(0, 4),  C0, 0);  GAPB(o[1] = A3_MFMA(PAF(0), VFR(1), o[1]), VRD(1, 5),  C0, 2); \
        GAPB(o[2] = A3_MFMA(PAF(0), VFR(2), o[2]), VRD(2, 6),  C0, 4);  GAPB(o[3] = A3_MFMA(PAF(0), VFR(3), o[3]), VRD(3, 7),  C0, 6); \
        GAPB(o[0] = A3_MFMA(PAF(1), VFR(0), o[0]), VRD(0, 8),  C0, 8);  GAPB(o[1] = A3_MFMA(PAF(1), VFR(1), o[1]), VRD(1, 9),  C0, 10); \
        GAPB(o[2] = A3_MFMA(PAF(1), VFR(2), o[2]), VRD(2, 10), C0, 12); GAPB(o[3] = A3_MFMA(PAF(1), VFR(3), o[3]), VRD(3, 11), C0, 14); \
        GAPB(o[0] = A3_MFMA(PAF(2), VFR(0), o[0]), VRD(0, 12), C1, 0);  GAPB(o[1] = A3_MFMA(PAF(2), VFR(1), o[1]), VRD(1, 13), C1, 2); \
        GAPB(o[2] = A3_MFMA(PAF(2), VFR(2), o[2]), VRD(2, 14), C1, 4);  GAPB(o[3] = A3_MFMA(PAF(2), VFR(3), o[3]), VRD(3, 15), C1, 6); \
        GAPB(o[0] = A3_MFMA(PAF(3), VFR(0), o[0]), (void)0, C1, 8);     GAPB(o[1] = A3_MFMA(PAF(3), VFR(1), o[1]), (void)0, C1, 10); \
        GAPB(o[2] = A3_MFMA(PAF(3), VFR(2), o[2]), (void)0, C1, 12);    GAPB(o[3] = A3_MFMA(PAF(3), VFR(3), o[3]), (void)0, C1, 14); \
        } while (0)
        int t = 1;
#pragma unroll 1
        for (; t + 5 < NT; t += 2) {
            STEP(pB0, pB1, pA0, pA1, t, false, true, true, true);     A3_WAIT_BAR(3); RESC(); ROT();
            STEP(pA0, pA1, pB0, pB1, t + 1, false, true, true, true); A3_WAIT_BAR(3); RESC(); ROT();
        }
#define ENDW(tt) do { if ((tt) + 3 < NT) { A3_WAIT_BAR(3); } else if ((tt) + 2 < NT) { A3_WAIT_BAR(2); } else { A3_WAIT_BAR(0); } } while (0)
#pragma unroll 1
        for (; t + 1 < NT; t += 2) {
            STEP(pB0, pB1, pA0, pA1, t, true, (t + 3 < NT), (t + 1 < NT), (t + 1 < NT));         ENDW(t);     RESC(); ROT();
            STEP(pA0, pA1, pB0, pB1, t + 1, true, (t + 4 < NT), (t + 2 < NT), (t + 2 < NT));     ENDW(t + 1); RESC(); ROT();
        }
        STEP(pB0, pB1, pA0, pA1, NT - 1, true, false, false, false); RESC();
        { float sacc = pB0[0] + pB0[1];
#pragma unroll
          for (int r = 2; r < 16; ++r) sacc += pB0[r];
#pragma unroll
          for (int r = 0; r < 16; ++r) sacc += pB1[r];
          l_reg += sacc;
          pw0 = (u32x4){PKW(pB0, 0), PKW(pB0, 2), PKW(pB0, 4), PKW(pB0, 6)}; pw1 = (u32x4){PKW(pB0, 8), PKW(pB0, 10), PKW(pB0, 12), PKW(pB0, 14)};
          pw2 = (u32x4){PKW(pB1, 0), PKW(pB1, 2), PKW(pB1, 4), PKW(pB1, 6)}; pw3 = (u32x4){PKW(pB1, 8), PKW(pB1, 10), PKW(pB1, 12), PKW(pB1, 14)};
          const lds_cptr vp_ = vp0 + sl_cur;
#pragma unroll
          for (int ks = 0; ks < 4; ++ks) {
#pragma unroll
              for (int d = 0; d < 4; ++d) VRD(d, ks * 4 + d);
              const bf16x8 pf = ks == 0 ? PAF(0) : ks == 1 ? PAF(1) : ks == 2 ? PAF(2) : PAF(3);
#pragma unroll
              for (int d = 0; d < 4; ++d) o[d] = A3_MFMA(pf, VFR(d), o[d]);
              A3_SBAR(); } }
        asm volatile("s_waitcnt lgkmcnt(0)\n\ts_barrier" ::: "memory");
#undef DMA_K
#undef DMA_V
#undef ROT
#undef RESC
#undef PKW
#undef PAF
#undef VFR
#undef VRD
#undef FO
#undef GAPA
#undef GAPB
#undef STEP
#undef ENDW
        float lt = sh32_sum(l_reg);
        if (hi == 0) wsf[r32] = 1.0f / lt;
        LDS_WAIT();
#pragma unroll
        for (int g4 = 0; g4 < 4; ++g4) { const f32x4 a4 = *(const LAS f32x4*)(wsf + 8 * g4 + 4 * hi);
#pragma unroll
            for (int d = 0; d < 4; ++d) { o[d][4 * g4] *= a4[0]; o[d][4 * g4 + 1] *= a4[1]; o[d][4 * g4 + 2] *= a4[2]; o[d][4 * g4 + 3] *= a4[3]; } }
        LDS_WAIT();
        int tid2 = tid; asm volatile("" : "+v"(tid2));
        const unsigned soff1 = (unsigned)(tid2 * 256);
        if (map == 0) {
#pragma unroll
            for (int d = 0; d < 4; ++d)
#pragma unroll
                for (int g4 = 0; g4 < 4; ++g4) { const f32x4 t4 = (f32x4){o[d][4 * g4], o[d][4 * g4 + 1], o[d][4 * g4 + 2], o[d][4 * g4 + 3]}; bst16(wsr, __builtin_bit_cast(u32x4, t4), soff1 + (d * 64 + g4 * 16), s_o1); }
        } else {
            float ss[16];
#pragma unroll
            for (int r = 0; r < 16; ++r) ss[r] = 0.f;
#pragma unroll
            for (int d = 0; d < 4; ++d)
#pragma unroll
                for (int g4 = 0; g4 < 4; ++g4) { const f32x4 a = __builtin_bit_cast(f32x4, bld16(wsr, soff1 + (d * 64 + g4 * 16), s_o1));
#pragma unroll
                    for (int q = 0; q < 4; ++q) { const float v = a[q] - lam * o[d][4 * g4 + q]; o[d][4 * g4 + q] = v; ss[4 * g4 + q] += v * v; } }
#pragma unroll
            for (int r = 0; r < 16; ++r) { float s = ss[r]; s += SHX(s, 1); s += SHX(s, 2); s += SHX(s, 4); s += SHX(s, 8); s += SHX(s, 16);
                ss[r] = rsqrtf(s * (1.0f / 128.0f) + EPS) * (1.0f - LAMBDA_INIT); }
            LAS unsigned char* stg = lds + wid * (32 * 272);
#pragma unroll
            for (int d = 0; d < 4; ++d) { const int r32b = tid2 & 31, hib = (tid2 >> 5) & 1; const float gg = gsub[d * 32 + r32b];
#pragma unroll
                for (int r = 0; r < 16; ++r) { const int row = (r & 3) + 8 * (r >> 2) + 4 * hib;
                    *(LAS bf16_t*)(stg + row * 272 + (d * 32 + r32b) * 2) = (bf16_t)(pk2(o[d][r] * ss[r] * gg, 0.f) & 0xffffu); } }
            LDS_WAIT();
            const unsigned s_y = (unsigned)WS_YCAT + ((tokbase + (unsigned)q0) * 1024u + 512u + (unsigned)h * 128u) * 2u;
            const int lane2 = tid2 & 63;
            const unsigned yoff = (unsigned)((lane2 >> 4) * 2048 + (lane2 & 15) * 16);
#pragma unroll 2
            for (int i = 0; i < 8; ++i) { const int row = i * 4 + (lane2 >> 4), ch = lane2 & 15;
                const u32x4 v = *(const LAS u32x4*)(stg + row * 272 + ch * 16);
                if (VAR == 0) bst16(wsr, v, yoff, s_y + (unsigned)i * 8192u); }
            LDS_WAIT();
            __syncthreads();
        }
    }
}


namespace pg8 {
constexpr int HTB = 128 * 64 * 2, STAGE_BYTES = 8 * HTB;
__device__ __forceinline__ int lds_byte(int r, int c) { const int st = (r >> 4) * 2 + (c >> 5), rr = r & 15, cc = c & 31, ob = rr * 64 + cc * 2; return st * 1024 + (ob ^ (((ob >> 9) & 1) << 5)); }
__device__ __forceinline__ void stage_rc(int b, int& R, int& C) { const int st = b / 1024, sb = b % 1024, swz = sb ^ (((sb >> 9) & 1) << 5); R = (st >> 1) * 16 + swz / 64; C = (st & 1) * 32 + (swz % 64) / 2; }
__device__ __forceinline__ int perm32(int rho) { const int n = rho >> 4, i = rho & 15; return 8 * (i >> 2) + 4 * n + (i & 3); }
struct Unit { int a, b, c, d, v; };
struct Off4 { unsigned h0i0, h0i1, h1i0, h1i1; };
typedef f32x4 Acc[2][2][4][2];
typedef int i32x4_t __attribute__((ext_vector_type(4)));

template <class Epi, class Src>
__device__ __forceinline__ void gemm_phase_w(LAS unsigned char* lds, const Src& S, Epi& E, int wv) {
    int tid = TID_OF(wv); asm volatile("" : "+v"(tid));
    const int wid = __builtin_amdgcn_readfirstlane(tid >> 6), lane = tid & 63, wr = wid >> 2, wc = wid & 3, fr = lane & 15, fq = lane >> 4;
    int nt = S.nt; const int bks = S.bks;
    int R[2], C[2], Rb[2][2];
#pragma unroll
    for (int i = 0; i < 2; ++i) { stage_rc(tid * 16 + i * 8192, R[i], C[i]);
#pragma unroll
        for (int h = 0; h < 2; ++h) Rb[h][i] = Epi::PERM == 2 ? (64 * (R[i] >> 5) + 16 * ((R[i] & 15) >> 2) + 8 * h + 4 * ((R[i] >> 4) & 1) + (R[i] & 3))
                                              : h * 128 + (Epi::PERM == 1 ? ((R[i] & ~31) + perm32(R[i] & 31)) : R[i]); }
    const Off4 vB = S.boff(Rb, C); Off4 oC, oN;
    const unsigned ldsw = (unsigned)wid * 1024u;
    const int aoff = lds_byte(wr * 64 + fr, fq * 8), boffl = lds_byte(wc * 32 + fr, fq * 8);
#define PG8_SA(b, h) (((b) * 2 + (h)) * pg8::HTB)
#define PG8_SB(b, h) ((4 + (b) * 2 + (h)) * pg8::HTB)
#define PG8_STAGE2(bufoff, ptr, o0, o1) do { \
        __builtin_amdgcn_global_load_lds((const unsigned*)((const char*)(ptr) + (o0)), (LAS unsigned*)(lds + (bufoff) + ldsw), 16, 0, 0); \
        __builtin_amdgcn_global_load_lds((const unsigned*)((const char*)(ptr) + (o1)), (LAS unsigned*)(lds + (bufoff) + ldsw + 8192), 16, 0, 0); } while (0)
#define PG8_STAGE_A(bufoff, ptr, off, h) PG8_STAGE2(bufoff, ptr, (h) ? (off).h1i0 : (off).h0i0, (h) ? (off).h1i1 : (off).h0i1)
#define PG8_STAGE_B(bufoff, ptr, h) PG8_STAGE2(bufoff, ptr, (h) ? vB.h1i0 : vB.h0i0, (h) ? vB.h1i1 : vB.h0i1)
#define PG8_LDA(dst, b, h) do { _Pragma("unroll") for (int m = 0; m < 4; ++m) _Pragma("unroll") for (int k = 0; k < 2; ++k) dst[m][k] = *(const LAS bf16x8*)(lds + PG8_SA(b, h) + aoff + m * 2048 + k * 1024); } while (0)
#define PG8_LDB(dst, b, h) do { _Pragma("unroll") for (int n = 0; n < 2; ++n) _Pragma("unroll") for (int k = 0; k < 2; ++k) dst[n][k] = *(const LAS bf16x8*)(lds + PG8_SB(b, h) + boffl + n * 2048 + k * 1024); } while (0)
#define PG8_CAT(x, y) __builtin_shufflevector(__builtin_bit_cast(i32x4_t, x), __builtin_bit_cast(i32x4_t, y), 0, 1, 2, 3, 4, 5, 6, 7)
#define PG8_MMA(ai, bj, At, Bt) do { __builtin_amdgcn_s_setprio(1); \
        if constexpr (Src::FP8) { _Pragma("unroll") for (int m = 0; m < 4; ++m) _Pragma("unroll") for (int n = 0; n < 2; ++n)        \
            acc[ai][bj][m][n] = __builtin_amdgcn_mfma_scale_f32_16x16x128_f8f6f4(PG8_CAT(Bt[n][0], Bt[n][1]), PG8_CAT(At[m][0], At[m][1]), acc[ai][bj][m][n], 0, 0, 0, 0x7f7f7f7f, 0, 0x7f7f7f7f); } \
        else { _Pragma("unroll") for (int m = 0; m < 4; ++m) _Pragma("unroll") for (int n = 0; n < 2; ++n) _Pragma("unroll") for (int k = 0; k < 2; ++k) \
            acc[ai][bj][m][n] = __builtin_amdgcn_mfma_f32_16x16x32_bf16(Bt[n][k], At[m][k], acc[ai][bj][m][n], 0, 0, 0); } \
        __builtin_amdgcn_s_setprio(0); } while (0)
#define PG8_WAIT_V(n) asm volatile("s_waitcnt vmcnt(" #n ")" ::: "memory")
#define PG8_WAIT_L(n) asm volatile("s_waitcnt lgkmcnt(" #n ")" ::: "memory")
#define PG8_BAR __builtin_amdgcn_s_barrier()
#define PG8_SCHED __builtin_amdgcn_sched_barrier(0)
    Unit cur, nxt; int ui = 0;
    if (!S.next(0, cur)) return;
    nt = S.ntu(cur);
    Acc acc;
#pragma unroll
    for (int a = 0; a < 2; ++a)
#pragma unroll
        for (int b = 0; b < 2; ++b)
#pragma unroll
            for (int m = 0; m < 4; ++m)
#pragma unroll
                for (int n = 0; n < 2; ++n) acc[a][b][m][n] = (f32x4){0.f, 0.f, 0.f, 0.f};
    bf16x8 At[4][2], B0[2][2], B1[2][2];
    oC = S.aoff(cur, R, C);
    const char* cA = S.abase(cur); const char* cB = S.bbase(cur);
    PG8_STAGE_B(PG8_SB(0, 0), cB, 0); PG8_STAGE_B(PG8_SB(0, 1), cB, 1); PG8_STAGE_A(PG8_SA(0, 0), cA, oC, 0); PG8_STAGE_A(PG8_SA(0, 1), cA, oC, 1);
    if (wr == 1) PG8_BAR;
    PG8_WAIT_V(2); PG8_BAR;
    PG8_STAGE_B(PG8_SB(1, 0), cB + bks, 0); PG8_STAGE_A(PG8_SA(1, 0), cA + 128, oC, 0); PG8_STAGE_B(PG8_SB(1, 1), cB + bks, 1);
    PG8_WAIT_V(6); PG8_BAR;
    for (;;) {
        const bool has_next = S.next(ui + 1, nxt);
        const char* nA = has_next ? S.abase(nxt) : cA; const char* nB = has_next ? S.bbase(nxt) : cB;
        oN = oC;
        if constexpr (Src::GATHER) { if (has_next) oN = S.aoff(nxt, R, C); }
        for (int t = 0; t < nt; t += 2) {
            const bool last = (t == nt - 2);
            if constexpr (Epi::HAS_PRE) { if (last) { int fr2 = fr; asm volatile("" : "+v"(fr2)); E.pre(cur, wr, fr2); } }
            const char* a1 = cA + (size_t)(t + 1) * 128;
            const char* a2 = last ? nA : cA + (size_t)(t + 2) * 128; const char* b2 = last ? nB : cB + (ptrdiff_t)(t + 2) * bks;
            const char* a3 = a2 + 128; const char* b3 = b2 + bks;
            PG8_LDB(B0, 0, 0); PG8_LDB(B1, 0, 1); PG8_SCHED; PG8_LDA(At, 0, 0); PG8_STAGE_A(PG8_SA(1, 1), a1, oC, 1);
            if constexpr (Src::GATHER) { if (last) oC = oN; }
            PG8_WAIT_V(8); PG8_WAIT_L(0); PG8_BAR; PG8_MMA(0, 0, At, B0); PG8_MMA(0, 1, At, B1); PG8_BAR; PG8_SCHED;
            PG8_LDA(At, 0, 1); PG8_STAGE_B(PG8_SB(0, 0), b2, 0); PG8_STAGE_B(PG8_SB(0, 1), b2, 1); PG8_STAGE_A(PG8_SA(0, 0), a2, oC, 0);
            PG8_WAIT_V(8); PG8_WAIT_L(0); PG8_BAR; PG8_MMA(1, 0, At, B0); PG8_MMA(1, 1, At, B1); PG8_BAR; PG8_SCHED;
            PG8_LDB(B0, 1, 0); PG8_LDB(B1, 1, 1); PG8_SCHED; PG8_LDA(At, 1, 0); PG8_STAGE_A(PG8_SA(0, 1), a2, oC, 1);
            PG8_WAIT_V(8); PG8_WAIT_L(0); PG8_BAR; PG8_MMA(0, 0, At, B0); PG8_MMA(0, 1, At, B1); PG8_BAR; PG8_SCHED;
            PG8_LDA(At, 1, 1); PG8_STAGE_B(PG8_SB(1, 0), b3, 0); PG8_STAGE_B(PG8_SB(1, 1), b3, 1); PG8_STAGE_A(PG8_SA(1, 0), a3, oC, 0);
            PG8_WAIT_V(8); PG8_WAIT_L(0); PG8_BAR; PG8_MMA(1, 0, At, B0); PG8_MMA(1, 1, At, B1); PG8_BAR; PG8_SCHED;
            if constexpr (Epi::HAS_MID) { if (t + 2 == Epi::MIDT) { int fr2 = fr; asm volatile("" : "+v"(fr2)); E.mid(acc, cur, wr, fr2); } }
        }
        if (wr == 0) PG8_BAR;
        { int fr2 = fr, fq2 = fq; asm volatile("" : "+v"(fr2), "+v"(fq2)); E(acc, cur, wr, wc, fr2, fq2); }
        if (!has_next) break;
#pragma unroll
        for (int a = 0; a < 2; ++a)
#pragma unroll
            for (int b = 0; b < 2; ++b)
#pragma unroll
                for (int m = 0; m < 4; ++m)
#pragma unroll
                    for (int n = 0; n < 2; ++n) acc[a][b][m][n] = (f32x4){0.f, 0.f, 0.f, 0.f};
        cur = nxt; cA = nA; cB = nB; ++ui; nt = S.ntu(cur);
        if (wr == 1) PG8_BAR;
    }
    PG8_WAIT_V(0);
    PG8_BAR;
#undef PG8_SA
#undef PG8_SB
#undef PG8_STAGE_A
#undef PG8_STAGE_B
#undef PG8_LDA
#undef PG8_LDB
#undef PG8_MMA
#undef PG8_CAT
#undef PG8_WAIT_V
#undef PG8_WAIT_L
#undef PG8_BAR
#undef PG8_SCHED
}

struct SrcPlain {
    static constexpr bool GATHER = false, FP8 = false;
    const char* A; const char* B; unsigned lda, ldb;
    size_t abatch, bbatch, abatch2, bbatch2; int nInner;
    int nM, nN, nBatch, G, c; int nt, bks;
    __device__ __forceinline__ int ntu(const Unit&) const { return nt; }
    __device__ __forceinline__ bool next(int i, Unit& u) const { const int L = i * G + c; if (L >= nM * nN * nBatch) return false; u.c = L / (nM * nN); const int r = L % (nM * nN); u.a = r / nN; u.b = r % nN; u.d = 0; return true; }
    __device__ __forceinline__ const char* abase(const Unit& u) const { return A + (size_t)(u.c / nInner) * abatch + (size_t)(u.c % nInner) * abatch2 + (size_t)u.a * 256 * lda; }
    __device__ __forceinline__ const char* bbase(const Unit& u) const { return B + (size_t)(u.c / nInner) * bbatch + (size_t)(u.c % nInner) * bbatch2 + (size_t)u.b * 256 * ldb; }
    __device__ __forceinline__ Off4 aoff(const Unit&, const int (&R)[2], const int (&C)[2]) const {
        Off4 o; o.h0i0 = (unsigned)R[0] * lda + (unsigned)C[0] * 2u; o.h0i1 = (unsigned)R[1] * lda + (unsigned)C[1] * 2u; o.h1i0 = o.h0i0 + 128u * lda; o.h1i1 = o.h0i1 + 128u * lda; return o; }
    __device__ __forceinline__ Off4 boff(const int (&Rb)[2][2], const int (&C)[2]) const {
        Off4 o; o.h0i0 = (unsigned)Rb[0][0] * ldb + (unsigned)C[0] * 2u; o.h0i1 = (unsigned)Rb[0][1] * ldb + (unsigned)C[1] * 2u; o.h1i0 = (unsigned)Rb[1][0] * ldb + (unsigned)C[0] * 2u; o.h1i1 = (unsigned)Rb[1][1] * ldb + (unsigned)C[1] * 2u; return o; }
};
}

#define E8_ROWS _Pragma("unroll") for (int ai = 0; ai < 2; ++ai) _Pragma("unroll") for (int m = 0; m < 4; ++m)
__device__ __forceinline__ u32x4 pk8(f32x4 a, f32x4 b) { u32x4 w; w.x = pk2(a[0], a[1]); w.y = pk2(a[2], a[3]); w.z = pk2(b[0], b[1]); w.w = pk2(b[2], b[3]); return w; }

struct EInproj8 {
    static constexpr int PERM = 1; static constexpr bool HAS_MID = false, HAS_PRE = false; static constexpr int MIDT = 0;
    bf16_t* U2; bf16_t* Q; bf16_t* K; bf16_t* V; const float* rope;
    __device__ __forceinline__ void operator()(pg8::Acc& acc, const pg8::Unit& u, int wr, int wc, int fr, int fq) {
        E8_ROWS { const int tok = u.a * 256 + ai * 128 + wr * 64 + m * 16 + fr;
#pragma unroll
            for (int bj = 0; bj < 2; ++bj) { const int col = u.b * 256 + bj * 128 + wc * 32 + 8 * fq; const f32x4 v0 = acc[ai][bj][m][0], v1 = acc[ai][bj][m][1];
                if (u.b < 2) { *(u32x4*)(U2 + ((size_t)(col >> 4) * NTOK + tok) * 16 + (col & 15)) = pk8(v0, v1); }
                else if (u.b >= 6) { *(u32x4*)(V + (size_t)tok * 512 + (col - 1536)) = pk8(v0, v1); }
                else { const int which = u.b >= 4, cc = col - (which ? 1024 : 512), j = (cc & 63) >> 1;
                    const f32x4 c0 = *(const f32x4*)(rope + ((size_t)tok * 32 + j) * 2), c1 = *(const f32x4*)(rope + ((size_t)tok * 32 + j) * 2 + 4);
                    f32x4 o0, o1; o0[0] = v0[0] * c0[0] - v0[1] * c0[1]; o0[1] = v0[1] * c0[0] + v0[0] * c0[1]; o0[2] = v0[2] * c0[2] - v0[3] * c0[3]; o0[3] = v0[3] * c0[2] + v0[2] * c0[3];
                    o1[0] = v1[0] * c1[0] - v1[1] * c1[1]; o1[1] = v1[1] * c1[0] + v1[0] * c1[1]; o1[2] = v1[2] * c1[2] - v1[3] * c1[3]; o1[3] = v1[3] * c1[2] + v1[2] * c1[3];
                    if (!which) { o0 = o0 * C2Q; o1 = o1 * C2Q; }
                    *(u32x4*)((which ? K : Q) + (size_t)tok * 512 + cc) = pk8(o0, o1); } } }
    }
};
struct EPlain8 {
    static constexpr int PERM = 1; static constexpr bool HAS_MID = false, HAS_PRE = false; static constexpr int MIDT = 0;
    bf16_t* out; size_t ldc; size_t obatch, obatch2; int nInner; const float* ssq; float cscale;
    __device__ __forceinline__ void operator()(pg8::Acc& acc, const pg8::Unit& u, int wr, int wc, int fr, int fq) {
        bf16_t* o = out + (size_t)(u.c / nInner) * obatch + (size_t)(u.c % nInner) * obatch2 + (size_t)u.a * 256 * ldc + u.b * 256;
        E8_ROWS { const int r = ai * 128 + wr * 64 + m * 16 + fr; float rs = cscale; if (ssq) rs *= rsqrtf(ssq_get<16>(ssq + (size_t)(u.a * 256 + r) * 16) * (1.0f / 1024.0f) + EPS);
#pragma unroll
            for (int bj = 0; bj < 2; ++bj) *(u32x4*)(o + (size_t)r * ldc + bj * 128 + wc * 32 + 8 * fq) = pk8(acc[ai][bj][m][0] * rs, acc[ai][bj][m][1] * rs); }
    }
};
__device__ __forceinline__ float sigm(float x) { return __builtin_amdgcn_rcpf(1.0f + __expf(-x)); }
struct EGlu8 {
    static constexpr int PERM = 1; static constexpr bool HAS_MID = false, HAS_PRE = false; static constexpr int MIDT = 0;
    const bf16_t* YG; bf16_t* YCAT; float* ssq;
    __device__ __forceinline__ void operator()(pg8::Acc& acc, const pg8::Unit& u, int wr, int wc, int fr, int fq) {
        E8_ROWS { const int tok = u.a * 256 + ai * 128 + wr * 64 + m * 16 + fr; float s = 0.f;
#pragma unroll
            for (int bj = 0; bj < 2; ++bj) { const int col = u.b * 256 + bj * 128 + wc * 32 + 8 * fq; const u32x4 yw = *(const u32x4*)(YG + (size_t)tok * 512 + col);
                const f32x4 a0 = acc[ai][bj][m][0], a1 = acc[ai][bj][m][1]; f32x4 o0, o1;
                o0[0] = bflo(yw.x) * sigm(a0[0]); o0[1] = bfhi(yw.x) * sigm(a0[1]); o0[2] = bflo(yw.y) * sigm(a0[2]); o0[3] = bfhi(yw.y) * sigm(a0[3]);
                o1[0] = bflo(yw.z) * sigm(a1[0]); o1[1] = bfhi(yw.z) * sigm(a1[1]); o1[2] = bflo(yw.w) * sigm(a1[2]); o1[3] = bfhi(yw.w) * sigm(a1[3]);
                s += (o0[0] * o0[0] + o0[1] * o0[1]) + (o0[2] * o0[2] + o0[3] * o0[3]) + (o1[0] * o1[0] + o1[1] * o1[1]) + (o1[2] * o1[2] + o1[3] * o1[3]);
                *(u32x4*)(YCAT + (size_t)tok * 1024 + col) = pk8(o0, o1); }
            ssq_put(s, ssq + (size_t)tok * 8 + u.b * 4 + wc, fq); }
    }
};
struct EOut8 {
    static constexpr int PERM = 1; static constexpr bool HAS_MID = true, HAS_PRE = false; static constexpr int MIDT = 8;
    const float* X; bf16_t* HB; const float* ssq_ssm; float* ssq1;
    __device__ __forceinline__ void mid(pg8::Acc& acc, const pg8::Unit& u, int wr, int fr) {
        E8_ROWS { const int tok = u.a * 256 + ai * 128 + wr * 64 + m * 16 + fr; const float rs = rsqrtf(ssq_get<8>(ssq_ssm + (size_t)tok * 8) * (1.0f / 512.0f) + EPS);
#pragma unroll
            for (int bj = 0; bj < 2; ++bj) { acc[ai][bj][m][0] = acc[ai][bj][m][0] * rs; acc[ai][bj][m][1] = acc[ai][bj][m][1] * rs; } }
    }
    __device__ __forceinline__ void operator()(pg8::Acc& acc, const pg8::Unit& u, int wr, int wc, int fr, int fq) {
        E8_ROWS { const int tok = u.a * 256 + ai * 128 + wr * 64 + m * 16 + fr; float s = 0.f;
#pragma unroll
            for (int bj = 0; bj < 2; ++bj) { const size_t o = (size_t)tok * 1024 + u.b * 256 + bj * 128 + wc * 32 + 8 * fq;
                const f32x4 h0 = __builtin_nontemporal_load((const f32x4*)(X + o)) + acc[ai][bj][m][0], h1 = __builtin_nontemporal_load((const f32x4*)(X + o + 4)) + acc[ai][bj][m][1];
                s += (h0[0] * h0[0] + h0[1] * h0[1]) + (h0[2] * h0[2] + h0[3] * h0[3]) + (h1[0] * h1[0] + h1[1] * h1[1]) + (h1[2] * h1[2] + h1[3] * h1[3]);
                *(u32x4*)(HB + o) = pk8(h0, h1); }
            ssq_put(s, ssq1 + (size_t)tok * 16 + u.b * 4 + wc, fq); }
    }
};
struct EWo8 {
    static constexpr int PERM = 1; static constexpr bool HAS_MID = false, HAS_PRE = false; static constexpr int MIDT = 0;
    const bf16_t* HBin; bf16_t* HBout; float* ssq2; unsigned char* hb8;
    __device__ __forceinline__ void operator()(pg8::Acc& acc, const pg8::Unit& u, int wr, int wc, int fr, int fq) {
        E8_ROWS { const int tok = u.a * 256 + ai * 128 + wr * 64 + m * 16 + fr; float s = 0.f;
#pragma unroll
            for (int bj = 0; bj < 2; ++bj) { const size_t o = (size_t)tok * 1024 + u.b * 256 + bj * 128 + wc * 32 + 8 * fq; const u32x4 w = *(const u32x4*)(HBin + o);
                f32x4 h0 = acc[ai][bj][m][0], h1 = acc[ai][bj][m][1];
                h0[0] += bflo(w.x); h0[1] += bfhi(w.x); h0[2] += bflo(w.y); h0[3] += bfhi(w.y); h1[0] += bflo(w.z); h1[1] += bfhi(w.z); h1[2] += bflo(w.w); h1[3] += bfhi(w.w);
                s += (h0[0] * h0[0] + h0[1] * h0[1]) + (h0[2] * h0[2] + h0[3] * h0[3]) + (h1[0] * h1[0] + h1[1] * h1[1]) + (h1[2] * h1[2] + h1[3] * h1[3]);
                *(u32x4*)(HBout + o) = pk8(h0, h1);
                if (hb8) *(u32x2*)(hb8 + o) = (u32x2){(unsigned)__builtin_amdgcn_cvt_pk_fp8_f32(h0[2], h0[3], __builtin_amdgcn_cvt_pk_fp8_f32(h0[0], h0[1], 0, false), true), (unsigned)__builtin_amdgcn_cvt_pk_fp8_f32(h1[2], h1[3], __builtin_amdgcn_cvt_pk_fp8_f32(h1[0], h1[1], 0, false), true)}; }
            ssq_put(s, ssq2 + (size_t)tok * 16 + u.b * 4 + wc, fq); }
    }
};
struct ESoftmax8 {
    static constexpr int PERM = 1; static constexpr bool HAS_MID = false, HAS_PRE = false; static constexpr int MIDT = 0;
    bf16_t* P; LAS float* red;
    __device__ __forceinline__ void operator()(pg8::Acc& acc, const pg8::Unit& u, int wr, int wc, int fr, int fq) {
        E8_ROWS { float v = -INFINITY;
#pragma unroll
            for (int bj = 0; bj < 2; ++bj)
#pragma unroll
                for (int n = 0; n < 2; ++n) v = fmaxf(fmaxf(v, fmaxf(acc[ai][bj][m][n][0], acc[ai][bj][m][n][1])), fmaxf(acc[ai][bj][m][n][2], acc[ai][bj][m][n][3]));
            v = fmaxf(v, SHX(v, 16)); v = sh32_max(v);
            if (fq == 0) red[(ai * 128 + wr * 64 + m * 16 + fr) * 4 + wc] = v; }
        LDS_WAIT(); __builtin_amdgcn_s_barrier(); asm volatile("" ::: "memory");
        E8_ROWS { const int r = ai * 128 + wr * 64 + m * 16 + fr; const f32x4 q = *(const LAS f32x4*)(red + r * 4); const float mm = fmaxf(fmaxf(q[0], q[1]), fmaxf(q[2], q[3])); float s = 0.f;
#pragma unroll
            for (int bj = 0; bj < 2; ++bj)
#pragma unroll
                for (int n = 0; n < 2; ++n) { f32x4 p; p[0] = __builtin_amdgcn_exp2f(acc[ai][bj][m][n][0] - mm); p[1] = __builtin_amdgcn_exp2f(acc[ai][bj][m][n][1] - mm); p[2] = __builtin_amdgcn_exp2f(acc[ai][bj][m][n][2] - mm); p[3] = __builtin_amdgcn_exp2f(acc[ai][bj][m][n][3] - mm);
                    acc[ai][bj][m][n] = p; s += (p[0] + p[1]) + (p[2] + p[3]); }
            s += SHX(s, 16); s = sh32_sum(s);
            if (fq == 0) red[1024 + r * 4 + wc] = s; }
        LDS_WAIT(); __builtin_amdgcn_s_barrier(); asm volatile("" ::: "memory");
        const int b = u.c >> 2, h = u.c & 3;
        bf16_t* o = P + ((size_t)b * SEQ + u.a * 256) * 1024 + h * 256;
        E8_ROWS { const int r = ai * 128 + wr * 64 + m * 16 + fr; const f32x4 q = *(const LAS f32x4*)(red + 1024 + r * 4); const float inv = 1.0f / ((q[0] + q[1]) + (q[2] + q[3]));
#pragma unroll
            for (int bj = 0; bj < 2; ++bj) *(u32x4*)(o + (size_t)r * 1024 + bj * 128 + wc * 32 + 8 * fq) = pk8(acc[ai][bj][m][0] * inv, acc[ai][bj][m][1] * inv); }
        LDS_WAIT(); __builtin_amdgcn_s_barrier(); asm volatile("" ::: "memory");
    }
};
template <bool F8OUT = false> struct EGateUp8T {
    static constexpr int PERM = 1; static constexpr bool HAS_MID = false, HAS_PRE = true; static constexpr int MIDT = 0;
    const float* slotw; const float* slotrs;
    const float* ssq2; bf16_t* HID;
    float asc = 1.0f, hsc = 1.0f;
    typedef _Float16 h2_t __attribute__((ext_vector_type(2)));
    h2_t wrs_[8];
    __device__ __forceinline__ void pre(const pg8::Unit& u, int wr, int fr) {
#pragma unroll
        for (int ai = 0; ai < 2; ++ai)
#pragma unroll
            for (int m = 0; m < 4; ++m) { const int r = ai * 128 + wr * 64 + m * 16 + fr; float w, rs;
                w = slotw[u.a + r] * hsc; rs = slotrs[u.a + r] * asc; if (r >= u.v) { w = 0.f; rs = 0.f; }
                wrs_[ai * 4 + m] = (h2_t){(_Float16)w, (_Float16)rs}; }
    }
    __device__ __forceinline__ void operator()(pg8::Acc& acc, const pg8::Unit& u, int wr, int wc, int fr, int fq) {
        E8_ROWS { const int r = ai * 128 + wr * 64 + m * 16 + fr; const float w = (float)wrs_[ai * 4 + m].x, rs = (float)wrs_[ai * 4 + m].y;
            f32x4 o[2];
#pragma unroll
            for (int n = 0; n < 2; ++n) { const f32x4 gg = acc[ai][0][m][n] * rs, uu = acc[ai][1][m][n] * rs;
#pragma unroll
                for (int i = 0; i < 4; ++i) o[n][i] = w * (gg[i] * sigm(gg[i])) * uu[i]; }
            if constexpr (F8OUT) *(u32x2*)((unsigned char*)HID + (size_t)(u.d + r) * 256 + u.b * 128 + wc * 32 + 8 * fq) =
                (u32x2){(unsigned)__builtin_amdgcn_cvt_pk_fp8_f32(o[0][2], o[0][3], __builtin_amdgcn_cvt_pk_fp8_f32(o[0][0], o[0][1], 0, false), true), (unsigned)__builtin_amdgcn_cvt_pk_fp8_f32(o[1][2], o[1][3], __builtin_amdgcn_cvt_pk_fp8_f32(o[1][0], o[1][1], 0, false), true)};
            else *(u32x4*)(HID + (size_t)(u.d + r) * 256 + u.b * 128 + wc * 32 + 8 * fq) = pk8(o[0], o[1]); }
    }
};
typedef EGateUp8T<false> EGateUp8;
struct EDownY8 {
    static constexpr int PERM = 2; static constexpr bool HAS_MID = false, HAS_PRE = true; static constexpr int MIDT = 0;
    const int* slot; int aid0; bf16_t* Y; float osc; int a_[8];
    __device__ __forceinline__ void pre(const pg8::Unit& u, int wr, int fr) {
#pragma unroll
        for (int ai = 0; ai < 2; ++ai)
#pragma unroll
            for (int m = 0; m < 4; ++m) { const int r = ai * 128 + wr * 64 + m * 16 + fr; int a = slot[u.a + r]; if (r >= u.v) a = -1; a_[ai * 4 + m] = a; }
    }
    __device__ __forceinline__ void operator()(pg8::Acc& acc, const pg8::Unit& u, int wr, int wc, int fr, int fq) {
        E8_ROWS { const int a = a_[ai * 4 + m];
            if (a >= 0) { unsigned char* p = (unsigned char*)Y + (size_t)(a - aid0) * 1024 + u.b * 256 + wc * 64 + 16 * fq;
                u32x4 w;
                { const f32x4 c0 = acc[ai][0][m][0] * osc, c1 = acc[ai][0][m][1] * osc, c2 = acc[ai][1][m][0] * osc, c3 = acc[ai][1][m][1] * osc;
                  w.x = __builtin_amdgcn_cvt_pk_fp8_f32(c0[2], c0[3], __builtin_amdgcn_cvt_pk_fp8_f32(c0[0], c0[1], 0, false), true);
                  w.y = __builtin_amdgcn_cvt_pk_fp8_f32(c1[2], c1[3], __builtin_amdgcn_cvt_pk_fp8_f32(c1[0], c1[1], 0, false), true);
                  w.z = __builtin_amdgcn_cvt_pk_fp8_f32(c2[2], c2[3], __builtin_amdgcn_cvt_pk_fp8_f32(c2[0], c2[1], 0, false), true);
                  w.w = __builtin_amdgcn_cvt_pk_fp8_f32(c3[2], c3[3], __builtin_amdgcn_cvt_pk_fp8_f32(c3[0], c3[1], 0, false), true); }
                __builtin_nontemporal_store(w, (u32x4*)p); } }
    }
};
struct EShared8 {
    static constexpr int PERM = 2; static constexpr bool HAS_MID = false, HAS_PRE = false; static constexpr int MIDT = 0;
    unsigned char* ys;
    __device__ __forceinline__ void operator()(pg8::Acc& acc, const pg8::Unit& u, int wr, int wc, int fr, int fq) {
        unsigned char* o = ys + (size_t)u.a * 256 * 1024 + u.b * 256 + wc * 64 + 16 * fq;
        E8_ROWS { const int r = ai * 128 + wr * 64 + m * 16 + fr; u32x4 w;
            const f32x4 c0 = acc[ai][0][m][0] * YSC, c1 = acc[ai][0][m][1] * YSC, c2 = acc[ai][1][m][0] * YSC, c3 = acc[ai][1][m][1] * YSC;
            w.x = __builtin_amdgcn_cvt_pk_fp8_f32(c0[2], c0[3], __builtin_amdgcn_cvt_pk_fp8_f32(c0[0], c0[1], 0, false), true);
            w.y = __builtin_amdgcn_cvt_pk_fp8_f32(c1[2], c1[3], __builtin_amdgcn_cvt_pk_fp8_f32(c1[0], c1[1], 0, false), true);
            w.z = __builtin_amdgcn_cvt_pk_fp8_f32(c2[2], c2[3], __builtin_amdgcn_cvt_pk_fp8_f32(c2[0], c2[1], 0, false), true);
            w.w = __builtin_amdgcn_cvt_pk_fp8_f32(c3[2], c3[3], __builtin_amdgcn_cvt_pk_fp8_f32(c3[0], c3[1], 0, false), true);
            __builtin_nontemporal_store(w, (u32x4*)(o + (size_t)r * 1024)); }
    }
};
__device__ __forceinline__ float gelu_rcp(float x) {
    const float u = 0.7978845608028654f * (x + 0.044715f * x * x * x);
    return x * __builtin_amdgcn_rcpf(1.0f + __expf(-2.0f * u));
}
struct EYstate8 {
    static constexpr int PERM = 1; static constexpr bool HAS_MID = false, HAS_PRE = false; static constexpr int MIDT = 0;
    const bf16_t* Y; bf16_t* YG;
    __device__ __forceinline__ void operator()(pg8::Acc& acc, const pg8::Unit& u, int wr, int wc, int fr, int fq) {
        E8_ROWS { const int rr = u.a * 256 + ai * 128 + wr * 64 + m * 16 + fr; const size_t tokb = (size_t)(rr >> 6) * SEQ + (rr & 63) * 64;
#pragma unroll
            for (int bj = 0; bj < 2; ++bj) { const int nn = u.b * 256 + bj * 128 + wc * 32 + 8 * fq; const size_t tok = tokb + (nn >> 4); const int c = nn & 15;
                const u32x4 yw = *(const u32x4*)(Y + ((size_t)u.c * NTOK + tok) * 16 + c);
                const f32x4 a0 = acc[ai][bj][m][0], a1 = acc[ai][bj][m][1]; f32x4 o0, o1;
                o0[0] = gelu_rcp(a0[0] + bflo(yw.x)); o0[1] = gelu_rcp(a0[1] + bfhi(yw.x)); o0[2] = gelu_rcp(a0[2] + bflo(yw.y)); o0[3] = gelu_rcp(a0[3] + bfhi(yw.y));
                o1[0] = gelu_rcp(a1[0] + bflo(yw.z)); o1[1] = gelu_rcp(a1[1] + bfhi(yw.z)); o1[2] = gelu_rcp(a1[2] + bflo(yw.w)); o1[3] = gelu_rcp(a1[3] + bfhi(yw.w));
                *(u32x4*)(YG + tok * 512 + u.c * 16 + c) = pk8(o0, o1); } }
    }
};
template <bool GATH, bool F8 = false> struct SrcMoe {
    static constexpr bool GATHER = GATH, FP8 = F8;
    const char* A; unsigned lda; const int* slot; int qbase;
    const char* B; unsigned ldb; size_t bexp; int nct;
    const LAS int* texp; int t0, nu, G, c; int nt, bks;
    int lq; const LAS int* pre; const LAS int* cnt;
    __device__ __forceinline__ int ntu(const pg8::Unit&) const { return nt; }
    __device__ __forceinline__ bool next(int i, pg8::Unit& u) const { const int L = i * G + c; if (L >= nu) return false; const int t = t0 + L / nct; u.b = L % nct;
        u.c = __builtin_amdgcn_readfirstlane(texp[t - t0]); u.d = t * 256 - qbase;
        { const int off = t * 256 - __builtin_amdgcn_readfirstlane(pre[u.c]); const int left = __builtin_amdgcn_readfirstlane(cnt[u.c]) - off; u.a = (lq + u.c) * LCAP + off; u.v = left < 0 ? 0 : (left > 256 ? 256 : left); }
        return true; }
    __device__ __forceinline__ const char* abase(const pg8::Unit& u) const { return GATH ? A : A + (size_t)u.d * lda; }
    __device__ __forceinline__ const char* bbase(const pg8::Unit& u) const { return B + (size_t)u.c * bexp + (size_t)u.b * 256 * ldb; }
    __device__ __forceinline__ unsigned rowoff(const pg8::Unit& u, int row) const { if (GATH) row = slot[u.a + min(row, u.v - 1)] >> 3;        return (unsigned)row * lda; }
    __device__ __forceinline__ pg8::Off4 aoff(const pg8::Unit& u, const int (&R)[2], const int (&C)[2]) const {
        pg8::Off4 o; o.h0i0 = rowoff(u, R[0]) + (unsigned)C[0] * 2u; o.h0i1 = rowoff(u, R[1]) + (unsigned)C[1] * 2u; o.h1i0 = rowoff(u, 128 + R[0]) + (unsigned)C[0] * 2u; o.h1i1 = rowoff(u, 128 + R[1]) + (unsigned)C[1] * 2u; return o; }
    __device__ __forceinline__ pg8::Off4 boff(const int (&Rb)[2][2], const int (&C)[2]) const {
        pg8::Off4 o; o.h0i0 = (unsigned)Rb[0][0] * ldb + (unsigned)C[0] * 2u; o.h0i1 = (unsigned)Rb[0][1] * ldb + (unsigned)C[1] * 2u; o.h1i0 = (unsigned)Rb[1][0] * ldb + (unsigned)C[0] * 2u; o.h1i1 = (unsigned)Rb[1][1] * ldb + (unsigned)C[1] * 2u; return o; }
};

struct SrcToep {
    static constexpr bool GATHER = false, FP8 = false;
    const char* U2p; const char* KDX; int G, c; int nt, bks; int nu = 1 << 30;
    __device__ __forceinline__ int ntu(const pg8::Unit& u) const { return 4 * (u.b + 1); }
    __device__ __forceinline__ bool next(int i, pg8::Unit& u) const { const int L = i * G + c; if (i >= nu || L >= 256) return false; u.c = L >> 3; u.a = (L >> 2) & 1; u.b = L & 3; u.d = 0; return true; }
    __device__ __forceinline__ const char* abase(const pg8::Unit& u) const { return U2p + ((size_t)u.c * NTOK * 16 + (size_t)u.a * 256 * 1024) * 2; }
    __device__ __forceinline__ const char* bbase(const pg8::Unit& u) const { return KDX + ((size_t)u.c * KDG + (size_t)u.b * 16 * 256) * 2; }
    __device__ __forceinline__ pg8::Off4 aoff(const pg8::Unit&, const int (&R)[2], const int (&C)[2]) const {
        pg8::Off4 o; o.h0i0 = (unsigned)R[0] * 2048u + (unsigned)C[0] * 2u; o.h0i1 = (unsigned)R[1] * 2048u + (unsigned)C[1] * 2u; o.h1i0 = o.h0i0 + 128u * 2048u; o.h1i1 = o.h0i1 + 128u * 2048u; return o; }
    __device__ __forceinline__ unsigned bo(int n, int C) const { return (unsigned)((((n >> 4) + 63 - (C >> 4)) * 256 + (n & 15) * 16 + (C & 15)) * 2); }
    __device__ __forceinline__ pg8::Off4 boff(const int (&Rb)[2][2], const int (&C)[2]) const { pg8::Off4 o; o.h0i0 = bo(Rb[0][0], C[0]); o.h0i1 = bo(Rb[0][1], C[1]); o.h1i0 = bo(Rb[1][0], C[0]); o.h1i1 = bo(Rb[1][1], C[1]); return o; }
};
struct ESsmT8 {
    static constexpr int PERM = 1; static constexpr bool HAS_MID = false, HAS_PRE = false; static constexpr int MIDT = 0;
    bf16_t* Y;
    __device__ __forceinline__ void operator()(pg8::Acc& acc, const pg8::Unit& u, int wr, int wc, int fr, int fq) {
        E8_ROWS { const int rr = u.a * 256 + ai * 128 + wr * 64 + m * 16 + fr; const size_t tokb = (size_t)(rr >> 6) * SEQ + (rr & 63) * 64;
#pragma unroll
            for (int bj = 0; bj < 2; ++bj) { const int nn = u.b * 256 + bj * 128 + wc * 32 + 8 * fq; bf16_t* p = Y + ((size_t)u.c * NTOK + tokb + (nn >> 4)) * 16 + (nn & 15);
                *(u32x4*)p = pk8(acc[ai][bj][m][0], acc[ai][bj][m][1]); } }
    }
};
struct ESsmS8 {
    static constexpr int PERM = 0; static constexpr bool HAS_MID = false, HAS_PRE = false; static constexpr int MIDT = 0;
    float* S;
    __device__ __forceinline__ void operator()(pg8::Acc& acc, const pg8::Unit& u, int wr, int wc, int fr, int fq) {
        E8_ROWS { const int rr = u.a * 256 + ai * 128 + wr * 64 + m * 16 + fr; float* p = S + ((size_t)u.c * 512 + rr) * 128 + wc * 32 + 4 * fq;
            *(f32x4*)p = acc[ai][0][m][0]; *(f32x4*)(p + 16) = acc[ai][0][m][1]; }
    }
};
struct Args { const void* in[37]; float* out; unsigned char* ws; int ph_lo, ph_hi; };
constexpr int NPHASE = 21;

__device__ __forceinline__ void ssm_pow(float lr, float li, float dt, float n, float& re, float& im) {
    const float mag = expf(n * lr * dt); float s, c; sincosf(n * (li * dt), &s, &c); re = mag * c; im = mag * s;
}
__device__ __forceinline__ void ssm_k(float lr, float li, float dt, float& kre, float& kim) {
    float ar, ai; ssm_pow(lr, li, dt, 1.0f, ar, ai); const float zr = ar - 1.0f, zi = ai, den = lr * lr + li * li;
    kre = (zr * lr + zi * li) / den; kim = (zi * lr - zr * li) / den;
}

__device__ __forceinline__ int rowmap(int kind, int n) {
    if (kind == 1) { if (n >= 512 && n < 1536) { const int j = n & 63; return (n & ~63) + (j < 32 ? 2 * j : 2 * (j - 32) + 1); } return n; }
    if (kind == 2) return (n >> 7) * 256 + (n & 127);
    if (kind == 3) return (n >> 7) * 256 + 128 + (n & 127);
    return n;
}
struct TrDesc { const float* src; bf16_t* dst; const float* kscale; int K, N, kind, klim, item; };
__device__ __forceinline__ void tr_load(const TrDesc& d, f32x4 (&v)[16], int lane) {
    const int nblk = d.N / 64, k0 = 64 * (d.item / nblk), n0 = 64 * (d.item % nblk), kr = lane >> 4, nc = (lane & 15) * 4;
#pragma unroll
    for (int r = 0; r < 16; ++r) v[r] = __builtin_nontemporal_load((const f32x4*)(d.src + (size_t)(k0 + r * 4 + kr) * d.N + n0 + nc));
}
__device__ __forceinline__ void tr_store(const TrDesc& d, const f32x4 (&v)[16], LAS unsigned char* scr, int lane) {
    const int nblk = d.N / 64, k0 = 64 * (d.item / nblk), n0 = 64 * (d.item % nblk), kr = lane >> 4, nc = (lane & 15) * 4;
#pragma unroll
    for (int r = 0; r < 16; ++r) { const int k = r * 4 + kr; f32x4 t = v[r]; if (d.kscale && (k0 + k) < d.klim) t = t * d.kscale[k0 + k];
        const unsigned w0 = pk2(t[0], t[1]), w1 = pk2(t[2], t[3]);
        *(LAS bf16_t*)(scr + (nc + 0) * 144 + k * 2) = (bf16_t)(w0 & 0xffffu); *(LAS bf16_t*)(scr + (nc + 1) * 144 + k * 2) = (bf16_t)(w0 >> 16);
        *(LAS bf16_t*)(scr + (nc + 2) * 144 + k * 2) = (bf16_t)(w1 & 0xffffu); *(LAS bf16_t*)(scr + (nc + 3) * 144 + k * 2) = (bf16_t)(w1 >> 16); }
    LDS_WAIT();
#pragma unroll
    for (int j = 0; j < 8; ++j) { const int id = lane + 64 * j, row = id >> 3, ch = id & 7;
        const u32x4 o = *(const LAS u32x4*)(scr + row * 144 + ch * 16);
        __builtin_nontemporal_store(o, (u32x4*)(d.dst + (size_t)rowmap(d.kind, n0 + row) * d.K + k0 + ch * 8)); }
    LDS_WAIT();
}
__device__ __forceinline__ void rms_row2_bf16(const float* xa, const float* xb, const float* g, bf16_t* oa, bf16_t* ob, int lane) {
    f32x4 va[4], vb[4]; float sa = 0.f, sb = 0.f;
#pragma unroll
    for (int j = 0; j < 4; ++j) { va[j] = __builtin_nontemporal_load((const f32x4*)(xa + (lane + 64 * j) * 4)); vb[j] = __builtin_nontemporal_load((const f32x4*)(xb + (lane + 64 * j) * 4)); }
#pragma unroll
    for (int j = 0; j < 4; ++j) { sa += (va[j][0] * va[j][0] + va[j][1] * va[j][1]) + (va[j][2] * va[j][2] + va[j][3] * va[j][3]); sb += (vb[j][0] * vb[j][0] + vb[j][1] * vb[j][1]) + (vb[j][2] * vb[j][2] + vb[j][3] * vb[j][3]); }
    const float ra = rsqrtf(wave_sum(sa) * (1.0f / 1024.0f) + EPS), rb = rsqrtf(wave_sum(sb) * (1.0f / 1024.0f) + EPS);
#pragma unroll
    for (int j = 0; j < 4; ++j) { const f32x4 gg = *(const f32x4*)(g + (lane + 64 * j) * 4); const f32x4 ta = va[j] * ra * gg, tb = vb[j] * rb * gg;
        __builtin_nontemporal_store((u32x2){pk2(ta[0], ta[1]), pk2(ta[2], ta[3])}, (u32x2*)(oa + (lane + 64 * j) * 4)); __builtin_nontemporal_store((u32x2){pk2(tb[0], tb[1]), pk2(tb[2], tb[3])}, (u32x2*)(ob + (lane + 64 * j) * 4)); }
}
__device__ __forceinline__ void rms_row_bf16(const float* xr, const float* g, bf16_t* orow, int lane) {
    f32x4 v[4]; float s = 0.f;
#pragma unroll
    for (int j = 0; j < 4; ++j) { v[j] = *(const f32x4*)(xr + (lane + 64 * j) * 4); s += (v[j][0] * v[j][0] + v[j][1] * v[j][1]) + (v[j][2] * v[j][2] + v[j][3] * v[j][3]); }
    const float rs = rsqrtf(wave_sum(s) * (1.0f / 1024.0f) + EPS);
#pragma unroll
    for (int j = 0; j < 4; ++j) { const f32x4 gg = *(const f32x4*)(g + (lane + 64 * j) * 4); st4bf(orow + (lane + 64 * j) * 4, v[j] * rs * gg); }
}


constexpr int CV_ITEMS = 3 * 64 * 64, CVW = 5;
__device__ __forceinline__ void tr_store8(const TrDesc& d, const f32x4 (&v)[16], LAS unsigned char* scr, int lane) {
    const int nblk = d.N / 64, k0 = 64 * (d.item / nblk), n0 = 64 * (d.item % nblk), kr = lane >> 4, nc = (lane & 15) * 4;
#pragma unroll
    for (int r = 0; r < 16; ++r) { const int k = r * 4 + kr; f32x4 t = v[r] * WSC8; if (d.kscale && (k0 + k) < d.klim) t = t * d.kscale[k0 + k];
        const unsigned w0 = (unsigned)__builtin_amdgcn_cvt_pk_fp8_f32(t[0], t[1], 0, false), w1 = (unsigned)__builtin_amdgcn_cvt_pk_fp8_f32(t[2], t[3], 0, false);
        *(LAS unsigned char*)(scr + (nc + 0) * 80 + k) = (unsigned char)(w0 & 0xffu); *(LAS unsigned char*)(scr + (nc + 1) * 80 + k) = (unsigned char)((w0 >> 8) & 0xffu);
        *(LAS unsigned char*)(scr + (nc + 2) * 80 + k) = (unsigned char)(w1 & 0xffu); *(LAS unsigned char*)(scr + (nc + 3) * 80 + k) = (unsigned char)((w1 >> 8) & 0xffu); }
    LDS_WAIT();
#pragma unroll
    for (int j = 0; j < 4; ++j) { const int id = lane + 64 * j, row = id >> 2, ch = id & 3;
        const u32x4 o = *(const LAS u32x4*)(scr + row * 80 + ch * 16);
        __builtin_nontemporal_store(o, (u32x4*)((unsigned char*)d.dst + (size_t)rowmap(d.kind, n0 + row) * d.K + k0 + ch * 16)); }
    LDS_WAIT();
}
__device__ __forceinline__ void cv_moe_item(int it, int lane, LAS unsigned char* scr, const float* wg, const float* wu, const float* wdn, const float* gffn, unsigned char* ws) {
    TrDesc d;
    if (it < 4096) d = TrDesc{wg + (size_t)(it >> 6) * 262144, (bf16_t*)(ws + WS_WGU + (size_t)(it >> 6) * 524288), gffn, 1024, 256, 2, 1024, it & 63};
    else if (it < 8192) d = TrDesc{wu + (size_t)((it - 4096) >> 6) * 262144, (bf16_t*)(ws + WS_WGU + (size_t)((it - 4096) >> 6) * 524288), gffn, 1024, 256, 3, 1024, it & 63};
    else d = TrDesc{wdn + (size_t)((it - 8192) >> 6) * 262144, (bf16_t*)(ws + WS_WD + (size_t)((it - 8192) >> 6) * 262144), nullptr, 256, 1024, 0, 0, it & 63};
    f32x4 v[16]; tr_load(d, v, lane); tr_store8(d, v, scr, lane);
}
__device__ __forceinline__ void xcd_barrier_cv(const XcdBarrier& b, LAS unsigned char* lds, int ord, int vcu, int G, const float* wg, const float* wu, const float* wdn, const float* gffn, unsigned char* ws) {

    asm volatile("s_waitcnt vmcnt(0)" ::: "memory");
    __syncthreads();
    if (TID_OF(b.w) == 0) {
        unsigned* bar = b.bar;
        __builtin_amdgcn_s_waitcnt(0);
        unsigned nloc = b.st[0], nx = b.st[1];
        if (nloc == 0u) { xcd_barrier_complete(bar, b.x, nloc, nx); b.st[0] = nloc; b.st[1] = nx; }
        const unsigned old = xb_add(&bar[XB_XSUB(b.x)], 1u);
        const unsigned gen = old / nloc;
        if (old + 1u == (gen + 1u) * nloc) {
            __builtin_amdgcn_fence(__ATOMIC_RELEASE, "agent");
            asm volatile("s_waitcnt vmcnt(0)" ::: "memory");
            (void)xb_add(&bar[XB_TOP], 1u);
        }
        XB_SPIN(xb_ld(&bar[XB_TOP]) < (gen + 1u) * nx, bar);
        __builtin_amdgcn_fence(__ATOMIC_ACQUIRE, "agent");
        asm volatile("s_waitcnt vmcnt(0)" ::: "memory");
    } else {
        int tid = TID_OF(b.w); asm volatile("" : "+v"(tid));
        const int wave = __builtin_amdgcn_readfirstlane(tid >> 6);
        if (wave >= 1 && wave <= CVW) { const int it = (ord * G + vcu) * CVW + (wave - 1); if (it < CV_ITEMS) cv_moe_item(it, tid & 63, lds + wave * 9216, wg, wu, wdn, gffn, ws); }
    }
    __syncthreads();
}

__global__ void __launch_bounds__(512, 2) fwd_kernel(Args args) {
    extern __shared__ __attribute__((aligned(16))) unsigned char lds_raw[];
    LAS unsigned char* lds = (LAS unsigned char*)lds_raw;
    int wv_s = __builtin_amdgcn_readfirstlane((int)threadIdx.x >> 6); asm volatile("" : "+s"(wv_s));
#define gemm_phase(l_, S_, e_) gemm_phase_w(l_, S_, e_, wv_s)
#define gemm_unit(l_, u_, e_) gemm_unit_w(l_, u_, e_, wv_s)
#define gemm_unit64(l_, u_, e_) gemm_unit64_w(l_, u_, e_, wv_s)
    const int G = gridDim.x; const int bx = blockIdx.x;
#define PHASE_TID() int tid = TID_OF(wv_s); asm volatile("" : "+v"(tid)); const int lane = tid & 63; const int wave = __builtin_amdgcn_readfirstlane(tid >> 6); \
    const int gw_ = vcu * 8 + wave, NGW = G * 8, gt_ = vcu * 512 + tid, NGT = G * 512; (void)lane; (void)gw_; (void)NGW; (void)gt_; (void)NGT;
    const int vcu = (G % 8 == 0) ? (bx % 8) * (G / 8) + bx / 8 : bx;
    unsigned char* ws = args.ws;
    unsigned* ctl = (unsigned*)(ws + WS_CTL);
    volatile LAS unsigned* MISC = (volatile LAS unsigned*)(lds + LDS_MISC);
    if (wv_s == 0) MISC[lane_id_v()] = 0u;
    __syncthreads();
#if MK_ONE_LAUNCH
    XcdBarrier bar = xcd_barrier_post(ctl + CW_BAR, MISC + 8, (unsigned)wv_s);
#define GRID_BAR() xcd_barrier(bar)
#define GRID_BAR_CV(o) xcd_barrier_cv(bar, lds, (o), vcu, G, (const float*)args.in[30], (const float*)args.in[31], (const float*)args.in[32], (const float*)args.in[27], ws)
#else
#define GRID_BAR() do {} while (0)
#define GRID_BAR_CV(o) do {} while (0)
#endif
    const int lo = args.ph_lo, hi_ = args.ph_hi;
#ifndef PHASE_MASK
#define PHASE_MASK 0xFFFFFFFFu
#endif
#define IN(k) (((PHASE_MASK >> (k)) & 1u) && lo <= (k) && (k) < hi_)
#define SEAM(k) do { if (IN(k) && IN((k) + 1)) { if ((k) <= 10 && (k) != 8) GRID_BAR_CV((k) <= 7 ? (k) : (k) - 1); else GRID_BAR(); } } while (0)
#ifndef REPEAT_MASK
#define REPEAT_MASK 0u
#endif
#define REPK(k) ((int)((REPEAT_MASK >> (k)) & 1u))

#define x_in ((const float*)args.in[0])
#define mem_in ((const float*)args.in[1])
#define positions ((const int*)args.in[2])
#define g_mix ((const float*)args.in[3])
#define w_in ((const float*)args.in[4])
#define a_re ((const float*)args.in[5])
#define a_im ((const float*)args.in[6])
#define log_dt ((const float*)args.in[7])
#define b_re ((const float*)args.in[8])
#define b_im ((const float*)args.in[9])
#define c_re ((const float*)args.in[10])
#define c_im ((const float*)args.in[11])
#define d_skip ((const float*)args.in[12])
#define w_glu ((const float*)args.in[13])
#define g_ssm_out ((const float*)args.in[14])
#define lam_q1 ((const float*)args.in[15])
#define lam_k1 ((const float*)args.in[16])
#define lam_q2 ((const float*)args.in[17])
#define lam_k2 ((const float*)args.in[18])
#define g_sub ((const float*)args.in[19])
#define w_out ((const float*)args.in[20])
#define g_x ((const float*)args.in[21])
#define g_mem ((const float*)args.in[22])
#define wq_x ((const float*)args.in[23])
#define wk_x ((const float*)args.in[24])
#define wv_x ((const float*)args.in[25])
#define wo_x ((const float*)args.in[26])
#define g_ffn ((const float*)args.in[27])
#define w_router ((const float*)args.in[28])
#define router_bias ((const float*)args.in[29])
#define w_gate ((const float*)args.in[30])
#define w_up ((const float*)args.in[31])
#define w_down ((const float*)args.in[32])
#define ws_gate ((const float*)args.in[33])
#define ws_up ((const float*)args.in[34])
#define ws_down ((const float*)args.in[35])
#define g_final ((const float*)args.in[36])
#define H (args.out)
#define WIN ((bf16_t*)(ws + WS_WIN))
#define WV ((bf16_t*)(ws + WS_WV))
#define WGLU ((bf16_t*)(ws + WS_WGLU))
#define WR ((bf16_t*)(ws + WS_WR))
#define WSD ((bf16_t*)(ws + WS_WSD))
#define WOUT ((bf16_t*)(ws + WS_WOUT))
#define WQX ((bf16_t*)(ws + WS_WQX))
#define WKX ((bf16_t*)(ws + WS_WKX))
#define WVX ((bf16_t*)(ws + WS_WVX))
#define WOX ((bf16_t*)(ws + WS_WOX))
#define WSGU ((bf16_t*)(ws + WS_WSGU))
#define WGU ((bf16_t*)(ws + WS_WGU))
#define WD ((bf16_t*)(ws + WS_WD))
#define WST ((bf16_t*)(ws + WS_WST))
#define WYT ((bf16_t*)(ws + WS_WYT))
#define KD ((bf16_t*)(ws + WS_KD))
#define POWT ((float*)(ws + WS_POWT))
#define BBAR ((float*)(ws + WS_BBAR))
#define ROPE ((float*)(ws + WS_ROPE))
#define MEMN ((bf16_t*)(ws + WS_MEMN))
#define KX ((bf16_t*)(ws + WS_KX))
#define VXT ((bf16_t*)(ws + WS_VXT))
#define SST ((float*)(ws + WS_S))
#define EST ((bf16_t*)(ws + WS_E))
#define LOGIT ((float*)(ws + WS_LOGIT))
#define EIDX ((int*)(ws + WS_EIDX))
#define GW ((float*)(ws + WS_GW))
#define SLOT ((int*)(ws + WS_SLOT))
#define XN ((bf16_t*)(ws + WS_A0))
#define YINTRA ((bf16_t*)(ws + WS_A0))
#define HB ((bf16_t*)(ws + WS_A0))
#define U2 ((bf16_t*)(ws + WS_U2))
#define Qb ((bf16_t*)(ws + WS_Q))
#define Kb ((bf16_t*)(ws + WS_K))
#define VT ((bf16_t*)(ws + WS_VT))
#define YCAT ((bf16_t*)(ws + WS_YCAT))
#define QX ((bf16_t*)(ws + WS_QX))
#define PX ((bf16_t*)(ws + WS_PX))
#define YG ((bf16_t*)(ws + WS_YG))
#define OX ((bf16_t*)(ws + WS_OX))
#define HID ((bf16_t*)(ws + WS_HID))
#define HIDS ((bf16_t*)(ws + WS_HIDS))
#define SSQ0 ((float*)(ws + WS_SSQP0))
#define SSQ1 ((float*)(ws + WS_SSQP1))
#define SSQ2 ((float*)(ws + WS_SSQP2))
#define BLKHIST ((int*)(ws + CB_BLKHIST))
#define CNT ((int*)(ctl + CW_CNT))

    if (IN(0)) for (int rep_ = 0; rep_ <= REPK(0); ++rep_) {
        PHASE_TID();
        LAS unsigned char* scr = lds + wave * 9216;
        for (int gb = vcu; gb < 256; gb += G) { const int g = gb >> 3, sub = gb & 7;
            LAS f32x2_t* PW = (LAS f32x2_t*)(lds + 73728); LAS f32x2_t* BBl = (LAS f32x2_t*)(lds + 73728 + 65 * 64 * 8);
            const float dt = expf(log_dt[g]);
            for (int i = tid; i < 65 * 64; i += 512) { const int p = i & 63, d = i >> 6; float pr, pi; ssm_pow(a_re[g * 64 + p], a_im[g * 64 + p], dt, (float)d, pr, pi); PW[i] = (f32x2_t){pr, pi}; }
            for (int i = tid; i < 64 * 16; i += 512) { const int p = i >> 4; float kre, kim; ssm_k(a_re[g * 64 + p], a_im[g * 64 + p], dt, kre, kim); const float br = b_re[g * 1024 + i], bi = b_im[g * 1024 + i];
                BBl[i] = (f32x2_t){kre * br - kim * bi, kre * bi + kim * br}; }
            __syncthreads();
            if (tid < 508) { const int item = sub * 508 + tid, hq = item & 1, c = (item >> 1) & 15, dd = item >> 5, d = dd - 63;
                float acc[8];
#pragma unroll
                for (int q = 0; q < 8; ++q) acc[q] = 0.f;
                if (d >= 0) { const float* cr = c_re + (g * 16 + c) * 64; const float* ci = c_im + (g * 16 + c) * 64;
#pragma unroll 4
                    for (int p = 0; p < 64; ++p) { const f32x2_t a = PW[d * 64 + p]; const float wre = cr[p] * a.x - ci[p] * a.y, wim = cr[p] * a.y + ci[p] * a.x;
#pragma unroll
                        for (int q = 0; q < 8; ++q) { const f32x2_t bq = BBl[p * 16 + hq * 8 + q]; acc[q] += wre * bq.x - wim * bq.y; } } }
                if (d == 0) {
#pragma unroll
                    for (int q = 0; q < 8; ++q) if (hq * 8 + q == c) acc[q] += d_skip[g * 16 + c]; }
                u32x4 o0; o0.x = pk2(acc[0], acc[1]); o0.y = pk2(acc[2], acc[3]); o0.z = pk2(acc[4], acc[5]); o0.w = pk2(acc[6], acc[7]);
                *(u32x4*)(KD + ((size_t)g * 127 * 32 + item) * 8) = o0; }
            { const int item = sub * 512 + tid, p = item >> 6, s = item & 63;
                const f32x2_t a = PW[(63 - s) * 64 + p]; float re[16], im[16];
#pragma unroll
                for (int q = 0; q < 16; ++q) { const f32x2_t bq = BBl[p * 16 + q]; re[q] = a.x * bq.x - a.y * bq.y; im[q] = a.x * bq.y + a.y * bq.x; }
                bf16_t* d0 = WST + ((size_t)(g * 256 + p) * 1024 + s * 16); bf16_t* d1 = WST + ((size_t)(g * 256 + 64 + p) * 1024 + s * 16);
                { const u32x4 z = (u32x4){0u, 0u, 0u, 0u}; *(u32x4*)(d0 + 128 * 1024) = z; *(u32x4*)(d0 + 128 * 1024 + 8) = z; *(u32x4*)(d1 + 128 * 1024) = z; *(u32x4*)(d1 + 128 * 1024 + 8) = z; }
                u32x4 o; o.x = pk2(re[0], re[1]); o.y = pk2(re[2], re[3]); o.z = pk2(re[4], re[5]); o.w = pk2(re[6], re[7]); *(u32x4*)d0 = o;
                o.x = pk2(re[8], re[9]); o.y = pk2(re[10], re[11]); o.z = pk2(re[12], re[13]); o.w = pk2(re[14], re[15]); *(u32x4*)(d0 + 8) = o;
                o.x = pk2(im[0], im[1]); o.y = pk2(im[2], im[3]); o.z = pk2(im[4], im[5]); o.w = pk2(im[6], im[7]); *(u32x4*)d1 = o;
                o.x = pk2(im[8], im[9]); o.y = pk2(im[10], im[11]); o.z = pk2(im[12], im[13]); o.w = pk2(im[14], im[15]); *(u32x4*)(d1 + 8) = o; }
#pragma unroll 2
            for (int j = 0; j < 8; ++j) { const int item = sub * 4096 + j * 512 + tid, p2 = (item & 31) * 2, c = (item >> 5) & 15, tp = item >> 9;
                const f32x2_t a0 = PW[(tp + 1) * 64 + p2], a1 = PW[(tp + 1) * 64 + p2 + 1];
                const float cr0 = c_re[(g * 16 + c) * 64 + p2], ci0 = c_im[(g * 16 + c) * 64 + p2], cr1 = c_re[(g * 16 + c) * 64 + p2 + 1], ci1 = c_im[(g * 16 + c) * 64 + p2 + 1];
                bf16_t* d = WYT + ((size_t)(g * 1024 + tp * 16 + c) * 128 + p2);
                *(unsigned*)d = pk2(cr0 * a0.x - ci0 * a0.y, cr1 * a1.x - ci1 * a1.y); *(unsigned*)(d + 64) = pk2(-(cr0 * a0.y + ci0 * a0.x), -(cr1 * a1.y + ci1 * a1.x)); }
            __syncthreads();
        }
        constexpr int I_IN = 512, I_GLU = 64, I_SQ = 256, I_R = 16, I_SG = 64, I_E = 64;
        constexpr int NIT = I_IN + I_GLU + 5 * I_SQ + I_R + 3 * I_SG + (MK_ONE_LAUNCH ? 0 : 3 * 64 * I_E);
        auto decode = [&](int it) -> TrDesc {
            int r = it;
            if (r < I_IN) return TrDesc{w_in, WIN, nullptr, 1024, 2048, 1, 0, r}; r -= I_IN;
            if (r < I_GLU) return TrDesc{w_glu, WGLU, nullptr, 512, 512, 0, 0, r}; r -= I_GLU;
            if (r < I_SQ) return TrDesc{w_out, WOUT, g_ssm_out, 1024, 1024, 0, 512, r}; r -= I_SQ;
            if (r < I_SQ) return TrDesc{wq_x, WQX, g_x, 1024, 1024, 0, 1024, r}; r -= I_SQ;
            if (r < I_SQ) return TrDesc{wk_x, WKX, nullptr, 1024, 1024, 0, 0, r}; r -= I_SQ;
            if (r < I_SQ) return TrDesc{wv_x, WVX, nullptr, 1024, 1024, 0, 0, r}; r -= I_SQ;
            if (r < I_SQ) return TrDesc{wo_x, WOX, nullptr, 1024, 1024, 0, 0, r}; r -= I_SQ;
            if (r < I_R) return TrDesc{w_router, WR, g_ffn, 1024, 64, 0, 1024, r}; r -= I_R;
            if (r < I_SG) return TrDesc{ws_gate, WSGU, g_ffn, 1024, 256, 2, 1024, r}; r -= I_SG;
            if (r < I_SG) return TrDesc{ws_up, WSGU, g_ffn, 1024, 256, 3, 1024, r}; r -= I_SG;
            if (r < I_SG) return TrDesc{ws_down, WSD, nullptr, 256, 1024, 0, 0, r}; r -= I_SG;
            if (r < 64 * I_E) { const int e = r / I_E; return TrDesc{w_gate + (size_t)e * 1024 * 256, WGU + (size_t)e * 512 * 1024, g_ffn, 1024, 256, 2, 1024, r % I_E}; } r -= 64 * I_E;
            if (r < 64 * I_E) { const int e = r / I_E; return TrDesc{w_up + (size_t)e * 1024 * 256, WGU + (size_t)e * 512 * 1024, g_ffn, 1024, 256, 3, 1024, r % I_E}; } r -= 64 * I_E;
            const int e = r / I_E; return TrDesc{w_down + (size_t)e * 256 * 1024, WD + (size_t)e * 1024 * 256, nullptr, 256, 1024, 0, 0, r % I_E};
        };
        constexpr int SH0 = I_IN + I_GLU + 5 * I_SQ + I_R;
        for (int it = gw_; it < SH0; it += NGW) { const TrDesc d0 = decode(it); f32x4 v0[16]; tr_load(d0, v0, lane); tr_store(d0, v0, scr, lane); }
        { int lane8 = lane; asm volatile("" : "+v"(lane8));
          for (int it = SH0 + gw_; it < SH0 + 3 * I_SG; it += NGW) { const TrDesc d0 = decode(it); f32x4 v0[16]; tr_load(d0, v0, lane8); tr_store8(d0, v0, scr, lane8); } }
        for (int m = gw_; m < NTOK; m += 2 * NGW) rms_row2_bf16(x_in + (size_t)m * 1024, x_in + (size_t)(m + NGW) * 1024, g_mix, XN + (size_t)m * 1024, XN + (size_t)(m + NGW) * 1024, lane);
        for (int m = gw_; m < NMEM; m += NGW) rms_row_bf16(mem_in + (size_t)m * 1024, g_mem, MEMN + (size_t)m * 1024, lane);
        for (int i = gt_; i < NTOK * 32; i += NGT) { const int tok = i >> 5, j = i & 31;
            const float inv = exp2f(-(float)(2 * j) * (13.287712379549449f / 64.0f)); const float ang = (float)positions[tok] * inv; float s, c; sincosf(ang, &s, &c);
            ROPE[(size_t)i * 2] = c; ROPE[(size_t)i * 2 + 1] = s; }
        if (bx == 0 && wave == 0) { float a = lam_q1[lane] * lam_k1[lane], b2 = lam_q2[lane] * lam_k2[lane]; a = wave_sum(a); b2 = wave_sum(b2);
            if (lane == 0) ((float*)ctl)[CW_LAM] = expf(a) - expf(b2) + LAMBDA_INIT; }
    }
    SEAM(0);
#if MK_ONE_LAUNCH
    if (REPK(29)) { for (int xb_ = 0; xb_ < 10; ++xb_) GRID_BAR(); }
#endif

    if (IN(1)) for (int rep_ = 0; rep_ <= REPK(1); ++rep_) {
        { pg8::SrcPlain S{(const char*)XN, (const char*)WIN, 2048u, 2048u, 0, 0, 0, 0, 1, 128, 8, 1, G, vcu, 16, 128};
          EInproj8 e{U2, Qb, Kb, VT, ROPE}; pg8::gemm_phase(lds, S, e); }
    }
    SEAM(1);

    if (IN(2)) for (int rep_ = 0; rep_ <= REPK(2); ++rep_) {
      if (G == 256) {
        const int cls = vcu >> 6, w = vcu & 63;
        if (cls == 0 || cls == 3) { SrcToep S{(const char*)U2, (const char*)KD, cls == 0 ? -3 : -1, cls == 0 ? 4 * w + 3 : 4 * w + 2, 16, -2048, 2}; ESsmT8 e{YINTRA}; pg8::gemm_phase(lds, S, e); }
        else if (cls == 1) { pg8::SrcPlain S{(const char*)U2, (const char*)WST, 2048u, 2048u, (size_t)NTOK * 32, (size_t)256 * 2048, 0, 0, 1, 2, 1, 32, 1 << 20, w, 16, 128};
          ESsmS8 e{SST}; pg8::gemm_phase(lds, S, e); }
        else if (w < 32) { pg8::SrcPlain S{(const char*)MEMN, (const char*)WKX, 2048u, 2048u, 0, 0, 0, 0, 1, 8, 4, 1, 1 << 20, w, 16, 128};
          EPlain8 e{KX, (size_t)1024, 0, 0, 1, nullptr, 1.0f}; pg8::gemm_phase(lds, S, e); }
        else { pg8::SrcPlain S{(const char*)WVX, (const char*)MEMN, 2048u, 2048u, 0, (size_t)256 * 2048, 0, 0, 1, 4, 1, 8, 1 << 20, w - 32, 16, 128};
          EPlain8 e{VXT, (size_t)256, (size_t)1024 * 256, 0, 1, nullptr, 1.0f}; pg8::gemm_phase(lds, S, e); }
      } else {
        { SrcToep S{(const char*)U2, (const char*)KD, G, vcu, 16, -2048}; ESsmT8 e{YINTRA}; pg8::gemm_phase(lds, S, e); }
        const bool bal = G == 256;
        { pg8::SrcPlain S{(const char*)U2, (const char*)WST, 2048u, 2048u, (size_t)NTOK * 32, (size_t)256 * 2048, 0, 0, 1, 2, 1, 32, bal ? (1 << 20) : G, bal ? ((vcu & 3) == 0 ? (vcu >> 2) : (1 << 20)) : vcu, 16, 128};
          ESsmS8 e{SST}; pg8::gemm_phase(lds, S, e); }
        constexpr int N_C = 16 * 4, N_D = 8 * 8;
        for (int i = bal ? ((vcu & 3) == 1 ? (vcu >> 2) : (vcu & 3) == 2 ? N_C + (vcu >> 2) : N_C + N_D) : vcu; i < N_C + N_D; i += bal ? N_C + N_D : G) { int r = i;
            if (r < N_C) { const int mt = r >> 2, nt = r & 3;
                UPlain u{(const char*)(MEMN + (size_t)mt * 128 * 1024), (const char*)(WKX + (size_t)nt * 256 * 1024), 2048u, 2048u, 16, 256};
                EPlain e{KX + (size_t)mt * 128 * 1024 + nt * 256, (size_t)1024, nullptr, 1.0f, 256}; gemm_unit(lds, u, e); }
            else { r -= N_C; const int b = r >> 3, mt = r & 7;
                UPlain u{(const char*)(WVX + (size_t)mt * 128 * 1024), (const char*)(MEMN + (size_t)b * 256 * 1024), 2048u, 2048u, 16, 256};
                EPlain e{VXT + ((size_t)(b * 1024 + mt * 128)) * 256, (size_t)256, nullptr, 1.0f, 256}; gemm_unit(lds, u, e); }
        }
      }
    }
    SEAM(2);

    if (IN(3)) for (int rep_ = 0; rep_ <= REPK(3); ++rep_) {
        PHASE_TID();
        for (int cg = vcu; cg < 256; cg += G) { const int p = lane, g = cg & 31, bb = cg >> 5;
            const float dt = expf(log_dt[g]); float ar, ai, ar8, ai8; ssm_pow(a_re[g * 64 + p], a_im[g * 64 + p], dt, 64.0f, ar, ai); ssm_pow(a_re[g * 64 + p], a_im[g * 64 + p], dt, 512.0f, ar8, ai8);
            const size_t base = ((size_t)g * 512 + bb * 64 + wave * 8) * 128 + p;
            float sr_[8], si_[8];
#pragma unroll
            for (int j = 0; j < 8; ++j) { sr_[j] = SST[base + (size_t)j * 128]; si_[j] = SST[base + (size_t)j * 128 + 64]; }
            float xr = 0.f, xi = 0.f;
#pragma unroll
            for (int j = 0; j < 8; ++j) { const float nr = ar * xr - ai * xi + sr_[j], ni = ar * xi + ai * xr + si_[j]; xr = nr; xi = ni; }
            LAS f32x2_t* seg = (LAS f32x2_t*)(lds + 118784);
            seg[wave * 64 + p] = (f32x2_t){xr, xi};
            __syncthreads();
            xr = 0.f; xi = 0.f;
            for (int w2 = 0; w2 < wave; ++w2) { const f32x2_t le = seg[w2 * 64 + p]; const float nr = ar8 * xr - ai8 * xi + le.x, ni = ar8 * xi + ai8 * xr + le.y; xr = nr; xi = ni; }
#pragma unroll
            for (int j = 0; j < 8; ++j) { const size_t o = base + (size_t)j * 128;
                EST[o] = (bf16_t)(pk2(xr, 0.f) & 0xffffu); EST[o + 64] = (bf16_t)(pk2(xi, 0.f) & 0xffffu);
                const float nr = ar * xr - ai * xi + sr_[j], ni = ar * xi + ai * xr + si_[j]; xr = nr; xi = ni; }
            __syncthreads();
        }
        const float lam = ((const float*)ctl)[CW_LAM];
        const rsrc_t wsr = __builtin_amdgcn_make_buffer_rsrc(ws, 0, 0x20000000, 0x00020000);
        for (int pi = vcu; pi < 256; pi += G) { const int bh = pi >> 3, s = pi & 7, b = bh >> 2, h = bh & 3;
#pragma unroll 1
            for (int uu = 0; uu < 2; ++uu) { if (rep_ == 0) attn_unit3<0>(lds, wsr, ws, b, h, uu ? s : 15 - s, lam, g_sub, bx, wv_s); else attn_unit3<PROBE_VAR>(lds, wsr, ws, b, h, uu ? s : 15 - s, lam, g_sub, bx, wv_s); } }
    }
    SEAM(3);

    if (IN(4)) for (int rep_ = 0; rep_ <= REPK(4); ++rep_) {
        int nt4 = 2; asm volatile("" : "+s"(nt4));
        pg8::SrcPlain S{(const char*)EST, (const char*)WYT, 256u, 256u, (size_t)512 * 256, (size_t)1024 * 256, 0, 0, 1, 2, 4, 32, G, vcu, nt4, 128};
        EYstate8 e{YINTRA, YG}; pg8::gemm_phase(lds, S, e);
    }
    SEAM(4);

    if (IN(5)) for (int rep_ = 0; rep_ <= REPK(5); ++rep_) {
        pg8::SrcPlain S{(const char*)YG, (const char*)WGLU, 1024u, 1024u, 0, 0, 0, 0, 1, 128, 2, 1, G, vcu, 8, 128};
        EGlu8 e{YG, YCAT, rep_ ? (float*)(ws + WS_O1S) : SSQ0}; pg8::gemm_phase(lds, S, e);
    }
    SEAM(5);

    if (IN(6)) for (int rep_ = 0; rep_ <= REPK(6); ++rep_) {
        pg8::SrcPlain S{(const char*)YCAT, (const char*)WOUT, 2048u, 2048u, 0, 0, 0, 0, 1, 128, 4, 1, G, vcu, 16, 128};
        EOut8 e{x_in, HB, SSQ0, rep_ ? (float*)(ws + WS_O1S) : SSQ1}; pg8::gemm_phase(lds, S, e);
    }
    SEAM(6);

    if (IN(7)) for (int rep_ = 0; rep_ <= REPK(7); ++rep_) {
        pg8::SrcPlain S{(const char*)HB, (const char*)WQX, 2048u, 2048u, 0, 0, 0, 0, 1, 128, 4, 1, G, vcu, 16, 128};
        EPlain8 e{QX, (size_t)1024, 0, 0, 1, SSQ1, CXQ}; pg8::gemm_phase(lds, S, e);
    }
    SEAM(7);

    if (IN(8)) for (int rep_ = 0; rep_ <= REPK(8); ++rep_) {
#pragma unroll 1
        for (int L = vcu; L < 512; L += G) {
            { pg8::SrcPlain S{(const char*)QX, (const char*)KX, 2048u, 2048u, (size_t)SEQ * 2048, (size_t)256 * 2048, 512, 512, 4, 16, 1, 32, 1 << 20, L, 4, 128};
              ESoftmax8 e{PX, (LAS float*)(lds + LDS_SCR8)}; pg8::gemm_phase(lds, S, e); }
            { pg8::SrcPlain S{(const char*)PX, (const char*)VXT, 2048u, 512u, (size_t)SEQ * 2048, (size_t)1024 * 512, 512, (size_t)256 * 512, 4, 16, 1, 32, 1 << 20, L, 4, 128};
              EPlain8 e{OX, (size_t)1024, (size_t)SEQ * 1024, 256, 4, nullptr, 1.0f}; pg8::gemm_phase(lds, S, e); }
        }
    }
    SEAM(9);

    if (IN(10)) for (int rep_ = 0; rep_ <= REPK(10); ++rep_) {
        pg8::SrcPlain S{(const char*)OX, (const char*)WOX, 2048u, 2048u, 0, 0, 0, 0, 1, 128, 4, 1, G, vcu, 16, 128};
        EWo8 e{HB, rep_ ? (bf16_t*)(ws + WS_PX) : HB, rep_ ? (float*)(ws + WS_O1S) : SSQ2, rep_ ? nullptr : ws + WS_HB8}; pg8::gemm_phase(lds, S, e);
    }
    SEAM(10);


    LAS int* lhist = (LAS int*)(lds + LDS_TAB);
    if (IN(12)) for (int rep_ = 0; rep_ <= REPK(12); ++rep_) {
        PHASE_TID();
        LAS int* le = (LAS int*)(lds); LAS float* lw = (LAS float*)(lds + 4096); LAS float* lr = (LAS float*)(lds + 8192);
        for (int vb = bx; vb < 256; vb += G) {
            if (tid < 64) lhist[tid] = 0;
            float ssq_t = 1.0f; if (tid < 128) ssq_t = ssq_get<16>(SSQ2 + (size_t)(vb * 128 + tid) * 16);
            { UPlain u{(const char*)(HB + (size_t)vb * 128 * 1024), (const char*)WR, 2048u, 2048u, 16, 64};
              ELdsF32 e{(LAS float*)(lds + LDS_SCR), SSQ2 + (size_t)vb * 128 * 16}; gemm_unit64(lds, u, e); }
            __syncthreads();
            if (tid < 128) { const int tk = vb * 128 + tid; const float rs_t = rsqrtf(ssq_t * (1.0f / 1024.0f) + EPS); lr[tid] = rs_t;
                if (rep_ == 0) { ((int*)(ws + WS_IDX8))[tk] = tk * 8; ((int*)(ws + WS_IDX1))[tk] = tk; ((float*)(ws + WS_SW1))[tk] = 1.0f; ((float*)(ws + WS_SRS1))[tk] = rs_t; } }
            const float rbias = router_bias[lane];
            for (int i = 0; i < 16; i += 2) {
                float sc[2], biased[2], cur[2], masked[2], wsum[2], myw[2]; int mye[2];
#pragma unroll
                for (int j = 0; j < 2; ++j) { sc[j] = sigm(((const LAS float*)(lds + LDS_SCR))[(wave * 16 + i + j) * 64 + lane]); biased[j] = sc[j] + rbias; }
                float m1[2], m2[2];
#pragma unroll
                for (int j = 0; j < 2; ++j) m1[j] = max8_dpp(biased[j]);
#pragma unroll
                for (int j = 0; j < 2; ++j) { const unsigned long long bl = __ballot(biased[j] == m1[j]); const unsigned gm = (unsigned)(bl >> (8 * (lane >> 3))) & 0xffu; const int first = __ffs((int)gm) - 1;
                    m2[j] = ((lane & 7) == first) ? -INFINITY : biased[j]; }
#pragma unroll
                for (int j = 0; j < 2; ++j) m2[j] = max8_dpp(m2[j]);
#pragma unroll
                for (int j = 0; j < 2; ++j) cur[j] = m1[j] + m2[j];
                int grank[2] = {0, 0};
#pragma unroll
                for (int g2 = 0; g2 < 8; ++g2)
#pragma unroll
                    for (int j = 0; j < 2; ++j) { const float s2 = __uint_as_float(__builtin_amdgcn_readlane(__float_as_uint(cur[j]), g2 * 8)); grank[j] += (s2 > cur[j] || (s2 == cur[j] && g2 < (lane >> 3))) ? 1 : 0; }
#pragma unroll
                for (int j = 0; j < 2; ++j) { masked[j] = (grank[j] < 4) ? biased[j] : -INFINITY; wsum[j] = 0.f; myw[j] = 0.f; mye[j] = 0; }
#pragma unroll
                for (int k = 0; k < 8; ++k) { float mx[2];
#pragma unroll
                    for (int j = 0; j < 2; ++j) mx[j] = wave_max_dpp(masked[j]);
#pragma unroll
                    for (int j = 0; j < 2; ++j) { const unsigned long long b2 = __ballot(masked[j] == mx[j]); const int e = __ffsll((long long)b2) - 1;
                        const float w = __uint_as_float(__builtin_amdgcn_readlane(__float_as_uint(sc[j]), __builtin_amdgcn_readfirstlane(e))); wsum[j] += w; if (lane == k) { mye[j] = e; myw[j] = w; } if (lane == e) masked[j] = -INFINITY; } }
#pragma unroll
                for (int j = 0; j < 2; ++j)
                    if (lane < 8) { le[(wave * 16 + i + j) * 8 + lane] = mye[j]; lw[(wave * 16 + i + j) * 8 + lane] = myw[j] / wsum[j] * 2.5f; (void)__hip_atomic_fetch_add(&lhist[mye[j]], 1, __ATOMIC_RELAXED, __HIP_MEMORY_SCOPE_WORKGROUP); } }
            __syncthreads();
            const int qv = vb >= QVB(2) ? 2 : (vb >= QVB(1) ? 1 : 0);
            if (tid < 64) lhist[64 + tid] = atomicAdd((rep_ ? (int*)(ws + WS_O1S) : CNT) + qv * 64 + tid, lhist[tid]);
            __syncthreads();
            if (rep_ == 0) {
#pragma unroll
                for (int hh = 0; hh < 2; ++hh) { const int idx = tid + hh * 512, e = le[idx]; const int pos = __hip_atomic_fetch_add(&lhist[64 + e], 1, __ATOMIC_RELAXED, __HIP_MEMORY_SCOPE_WORKGROUP);
                    const size_t li = (size_t)(qv * 64 + e) * LCAP + pos; ((int*)(ws + WS_LSLOT))[li] = vb * 1024 + idx; ((float*)(ws + WS_LW))[li] = lw[idx]; ((float*)(ws + WS_LRS))[li] = lr[idx >> 3]; } }
            __syncthreads();
        }
    }
    SEAM(12);

    if (hi_ > 14) {
        PHASE_TID();
        if (tid < NQ * 64) { const int cn_ = CNT[tid]; lhist[512 + tid] = (cn_ + 255) & ~255; lhist[704 + tid] = cn_; }
        if (tid == 0) { lhist[1664] = 0; lhist[1665] = NTOK; }
        if (tid < 128) lhist[1536 + tid] = 0;
        __syncthreads();
        if (tid <= NQ * 64) { int s = 0; for (int e = 0; e < tid; ++e) s += lhist[512 + e]; lhist[128 + tid] = s; }
        __syncthreads();
    }
#pragma unroll 1
    for (int q = 0; q <= NQ; ++q) {
        const int pa = 14 + 2 * q, pb = 15 + 2 * q;
        if (q < NQ && hi_ > 14) {
            int tid = TID_OF(wv_s); asm volatile("" : "+v"(tid));
            __syncthreads();
            const int qb_ = lhist[128 + q * 64] >> 8, nt_ = (lhist[128 + (q + 1) * 64] >> 8) - qb_;
            for (int t = tid; t < nt_; t += 512) { int e = 0;
                for (int s = 32; s > 0; s >>= 1) if (lhist[128 + q * 64 + e + s] <= (qb_ + t) * 256) e += s;
                lhist[1024 + t] = e; }
            __syncthreads();
        }
        if (IN(pa)) for (int step = 0; step < 2; ++step) {
            const bool do_comb = (step == 0) == (((vcu >> 1) & 1) == 0);
            if (do_comb && q > 0) {
                PHASE_TID();
                const unsigned char* Yq = ws + WS_Y;
                LAS float* tsc = (LAS float*)(lds + wave * 4096);
                const int tk0 = QVB(q - 1) * 128, ntk = (QVB(q) - QVB(q - 1)) * 128;
                for (int m = gw_; m < ntk; m += NGW) { const int tok = tk0 + m; float* hr = H + (size_t)tok * 1024; f32x4 v[4]; float s = 0.f;
                    const bf16_t* hb = HB + (size_t)tok * 1024;
                    u32x2 wh[4];
#pragma unroll
                    for (int j = 0; j < 4; ++j) wh[j] = __builtin_nontemporal_load((const u32x2*)(hb + (lane + 64 * j) * 4));
                    u32x4 yr[9];
#pragma unroll
                    for (int k = 0; k < 8; ++k) yr[k] = __builtin_nontemporal_load((const u32x4*)(Yq + ((size_t)m * 8 + k) * 1024 + lane * 16));
                    yr[8] = __builtin_nontemporal_load((const u32x4*)(ws + WS_YSLO + (size_t)tok * 1024 + lane * 16));
                    float a16[16];
#pragma unroll
                    for (int c = 0; c < 16; ++c) a16[c] = 0.f;
#pragma unroll
                    for (int k = 0; k < 9; ++k)
#pragma unroll
                        for (int c = 0; c < 4; ++c) { const unsigned w = c == 0 ? yr[k].x : c == 1 ? yr[k].y : c == 2 ? yr[k].z : yr[k].w;
                            const f32x2_t lo = __builtin_amdgcn_cvt_pk_f32_fp8(w, false), hi2 = __builtin_amdgcn_cvt_pk_f32_fp8(w, true);
                            a16[4 * c] += lo[0]; a16[4 * c + 1] += lo[1]; a16[4 * c + 2] += hi2[0]; a16[4 * c + 3] += hi2[1]; }
#pragma unroll
                    for (int c = 0; c < 4; ++c) *(LAS f32x4*)(tsc + lane * 16 + 4 * c) = (f32x4){a16[4 * c], a16[4 * c + 1], a16[4 * c + 2], a16[4 * c + 3]} * (1.0f / YSC);
                    LDS_WAIT();
#pragma unroll
                    for (int j = 0; j < 4; ++j) { const f32x4 t = *(const LAS f32x4*)(tsc + (lane + 64 * j) * 4);
                        v[j][0] = t[0] + bflo(wh[j].x); v[j][1] = t[1] + bfhi(wh[j].x); v[j][2] = t[2] + bflo(wh[j].y); v[j][3] = t[3] + bfhi(wh[j].y); }
                    LDS_WAIT();
#pragma unroll
                    for (int j = 0; j < 4; ++j) s += (v[j][0] * v[j][0] + v[j][1] * v[j][1]) + (v[j][2] * v[j][2] + v[j][3] * v[j][3]);
                    const float rs = rsqrtf(wave_sum(s) * (1.0f / 1024.0f) + EPS);
#pragma unroll
                    for (int j = 0; j < 4; ++j) { const f32x4 gg = *(const f32x4*)(g_final + (lane + 64 * j) * 4); __builtin_nontemporal_store(v[j] * rs * gg, (f32x4*)(hr + (lane + 64 * j) * 4)); } }
                __syncthreads();
            }
#ifndef NO_GU
            if (!do_comb && q < NQ) {
                const int qbase = __builtin_amdgcn_readfirstlane(lhist[128 + q * 64]), t0 = qbase >> 8, t1 = __builtin_amdgcn_readfirstlane(lhist[128 + (q + 1) * 64]) >> 8;
                { SrcMoe<true, true> S{(const char*)(ws + WS_HB8), 1024u, (const int*)(ws + WS_LSLOT), qbase, (const char*)WGU, 1024u, (size_t)512 * 1024, 2, lhist + 1024, t0, (t1 - t0) * 2, G, vcu, 8, 128, q * 64, lhist + 128 + q * 64, lhist + 704 + q * 64};
                  EGateUp8T<true> ep{(const float*)(ws + WS_LW), (const float*)(ws + WS_LRS), SSQ2, HID, 1.0f / WSC8, HSC8}; for (int rep_ = 0; rep_ <= REPK(14); ++rep_) pg8::gemm_phase(lds, S, ep); }
                if (q == 0) { SrcMoe<true, true> S{(const char*)(ws + WS_HB8), 1024u, (const int*)(ws + WS_IDX8), 0, (const char*)WSGU, 1024u, 0, 2, lhist + 1536, 0, 128 * 2, G, vcu, 8, 128, 0, lhist + 1664, lhist + 1665};
                  EGateUp8T<true> ep{(const float*)(ws + WS_SW1), (const float*)(ws + WS_SRS1), SSQ2, HIDS, 1.0f / WSC8, HSC8}; pg8::gemm_phase(lds, S, ep); }
            }
#endif
        }
        if (q < NQ) SEAM(pa);
#ifndef NO_DN
        if (IN(pb) && q < NQ) {
            const int qbase = __builtin_amdgcn_readfirstlane(lhist[128 + q * 64]), t0 = qbase >> 8, t1 = __builtin_amdgcn_readfirstlane(lhist[128 + (q + 1) * 64]) >> 8;
            { SrcMoe<false, true> S{(const char*)HID, 256u, (const int*)(ws + WS_LSLOT), qbase, (const char*)WD, 256u, (size_t)1024 * 256, 4, lhist + 1024, t0, (t1 - t0) * 4, G, vcu, 2, 128, q * 64, lhist + 128 + q * 64, lhist + 704 + q * 64};
              EDownY8 ep{(const int*)(ws + WS_LSLOT), QVB(q) * 128 * 8, (bf16_t*)(ws + WS_Y), YSC / (HSC8 * WSC8)}; for (int rep_ = 0; rep_ <= REPK(15); ++rep_) pg8::gemm_phase(lds, S, ep); }
            if (q == 0) { SrcMoe<false, true> S{(const char*)HIDS, 256u, (const int*)(ws + WS_IDX1), 0, (const char*)WSD, 256u, 0, 4, lhist + 1536, 0, 128 * 4, G, vcu, 2, 128, 0, lhist + 1664, lhist + 1665};
              EDownY8 ep{(const int*)(ws + WS_IDX1), 0, (bf16_t*)(ws + WS_YSLO), YSC / (HSC8 * WSC8)}; pg8::gemm_phase(lds, S, ep); }
        }
#endif
        if (q < NQ) SEAM(pb);
    }
#undef IN
#undef SEAM
}
#undef x_in
#undef mem_in
#undef positions
#undef g_mix
#undef w_in
#undef a_re
#undef a_im
#undef log_dt
#undef b_re
#undef b_im
#undef c_re
#undef c_im
#undef d_skip
#undef w_glu
#undef g_ssm_out
#undef lam_q1
#undef lam_k1
#undef lam_q2
#undef lam_k2
#undef g_sub
#undef w_out
#undef g_x
#undef g_mem
#undef wq_x
#undef wk_x
#undef wv_x
#undef wo_x
#undef g_ffn
#undef w_router
#undef router_bias
#undef w_gate
#undef w_up
#undef w_down
#undef ws_gate
#undef ws_up
#undef ws_down
#undef g_final
#undef H
#undef WIN
#undef WV
#undef WGLU
#undef WR
#undef WSD
#undef WOUT
#undef WQX
#undef WKX
#undef WVX
#undef WOX
#undef WSGU
#undef WGU
#undef WD
#undef WST
#undef WYT
#undef KD
#undef POWT
#undef BBAR
#undef ROPE
#undef MEMN
#undef KX
#undef VXT
#undef SST
#undef EST
#undef LOGIT
#undef EIDX
#undef GW
#undef SLOT
#undef XN
#undef YINTRA
#undef HB
#undef U2
#undef Qb
#undef Kb
#undef VT
#undef YCAT
#undef QX
#undef PX
#undef YG
#undef OX
#undef HID
#undef HIDS
#undef SSQ0
#undef SSQ1
#undef SSQ2
#undef BLKHIST
#undef CNT


extern "C" void kernel_launch(void* const* d_in, const int* in_sizes, int n_in, void* d_out, int out_size, void* d_ws, size_t ws_size, hipStream_t stream) {
    static int grid = 0;
    if (grid == 0) {
        if (n_in != 37 || out_size != NTOK * DM || ws_size < WS_END) { fprintf(stderr, "kernel_launch: unexpected problem (n_in %d out %d ws %zu)\n", n_in, out_size, ws_size); grid = -1; return; }
        int dev = 0, cus = 0, per_cu = 0;
        if (hipGetDevice(&dev) != hipSuccess || hipDeviceGetAttribute(&cus, hipDeviceAttributeMultiprocessorCount, dev) != hipSuccess) { grid = -1; return; }
        if (hipFuncSetAttribute((const void*)fwd_kernel, hipFuncAttributeMaxDynamicSharedMemorySize, LDS_BYTES) != hipSuccess) { fprintf(stderr, "kernel_launch: hipFuncSetAttribute failed\n"); grid = -1; return; }
        if (hipOccupancyMaxActiveBlocksPerMultiprocessor(&per_cu, (const void*)fwd_kernel, 512, LDS_BYTES) != hipSuccess || per_cu < 1) { fprintf(stderr, "kernel_launch: occupancy query says %d\n", per_cu); per_cu = 1; }
        (void)hipGetLastError();
        grid = cus;
    }
    if (grid < 0) return;
    (void)hipMemsetAsync((char*)d_ws + WS_CTL, 0, CTL_BYTES, stream);
    Args a{};
    for (int i = 0; i < 37; ++i) a.in[i] = d_in[i];
    a.out = (float*)d_out; a.ws = (unsigned char*)d_ws;
#if MK_ONE_LAUNCH
    a.ph_lo = 0; a.ph_hi = NPHASE;
    hipLaunchKernelGGL(fwd_kernel, dim3(grid), dim3(512), LDS_BYTES, stream, a);
#else
    for (int p = 0; p < NPHASE; ++p) { a.ph_lo = p; a.ph_hi = p + 1; hipLaunchKernelGGL(fwd_kernel, dim3(grid), dim3(512), LDS_BYTES, stream, a); }
#endif
}
```
